# Optimizing an MI355X kernel written in HIP

```python
import jax, jax.numpy as jnp
from jax import lax
import numpy as np

D_MODEL = 1024
BATCH = 2
SEQ = 16384
DEPTH = 4

CHUNK = 64
N_META = 16
N_EVEN = (DEPTH + 1) // 2
N_ODD = DEPTH // 2
EPS = 1e-6
D_FF = 4 * D_MODEL

HG_HEADS = 4
HG_K = 128
HG_V = (D_MODEL // 2) // HG_HEADS
HG_KW = HG_HEADS * HG_K
HG_VW = HG_HEADS * HG_V

MLA_HEADS = 4
NOPE = 128
ROPE = 64
V_DIM = (D_MODEL // 2) // MLA_HEADS
QK_DIM = NOPE + ROPE
Q_RANK = 256
KV_RANK = 256
ROPE_THETA = 10000.0
Q_BLOCK = 128

IN_SPLITS = (HG_KW, 2 * HG_KW, 2 * HG_KW + HG_VW, 2 * HG_KW + 2 * HG_VW,
             2 * HG_KW + 2 * HG_VW + Q_RANK, 2 * HG_KW + 2 * HG_VW + Q_RANK + KV_RANK)
IN_COLS = 2 * HG_KW + 2 * HG_VW + Q_RANK + KV_RANK + ROPE

POOL_WINDOWS = (2, 4, 8, 16)
POOL_GROUPS = len(POOL_WINDOWS)
POOL_G = D_MODEL // POOL_GROUPS

kernel_name = "hybrid_hgrn2_mla_pool_trunk"


def rmsnorm(x, g):
    xf = x.astype(jnp.float32)
    y = xf * lax.rsqrt(jnp.mean(xf * xf, axis=-1, keepdims=True) + EPS)
    return (y * g.astype(jnp.float32)).astype(x.dtype)


def chunk_ids(L):
    p = jnp.arange(L)
    return jnp.where(p < N_META, 0, 1 + (p - N_META) // CHUNK)


def rope_tables(L):
    half = ROPE // 2
    inv = ROPE_THETA ** (-jnp.arange(half, dtype=jnp.float32) / half)
    ang = jnp.arange(L, dtype=jnp.float32)[:, None] * inv[None, :]
    return jnp.cos(ang), jnp.sin(ang)


def rope_tail(x, cos, sin):
    xn, xr = x[..., :NOPE], x[..., NOPE:]
    x1, x2 = xr[..., :ROPE // 2], xr[..., ROPE // 2:]
    c = cos[None, :, None, :].astype(x.dtype)
    s = sin[None, :, None, :].astype(x.dtype)
    return jnp.concatenate([xn, x1 * c - x2 * s, x2 * c + x1 * s], axis=-1)


def hgrn2_chunk_scan(q, k, v, log_f):
    B, L, H, K = q.shape
    lead = CHUNK - N_META
    tail = (-(L + lead)) % CHUNK
    nc = (L + lead + tail) // CHUNK

    def to_chunks(a):
        a = jnp.pad(a.astype(jnp.float32), ((0, 0), (lead, tail), (0, 0), (0, 0)))
        return a.reshape(B, nc, CHUNK, H, a.shape[-1]).transpose(1, 0, 3, 2, 4)

    qc, kc, vc, gc = to_chunks(q), to_chunks(k), to_chunks(v), to_chunks(log_f)
    tri = jnp.tril(jnp.ones((CHUNK, CHUNK), dtype=bool))[:, :, None]

    def step(S, inp):
        qi, ki, vi, gi = inp
        b = jnp.cumsum(gi, axis=2)
        o_inter = jnp.einsum('bhtk,bhkv->bhtv', qi * jnp.exp(b), S)
        diff = b[:, :, :, None, :] - b[:, :, None, :, :]
        dec = jnp.exp(jnp.where(tri, diff, -jnp.inf))
        att = jnp.einsum('bhtk,bhtsk,bhsk->bhts', qi, dec, ki)
        o_intra = jnp.einsum('bhts,bhsv->bhtv', att, vi)
        b_last = b[:, :, -1:, :]
        S_new = jnp.exp(b_last[:, :, 0, :])[..., None] * S + jnp.einsum(
            'bhsk,bhsv->bhkv', ki * jnp.exp(b_last - b), vi)
        return S_new, o_inter + o_intra

    S0 = jnp.zeros((B, H, K, v.shape[-1]), jnp.float32)
    _, o = lax.scan(step, S0, (qc, kc, vc, gc))
    o = o.transpose(1, 0, 3, 2, 4).reshape(B, nc * CHUNK, H, -1)
    return o[:, lead:lead + L]


def hgrn2_mixer(hq, hf, hi, hg, lb, out_gain):
    B, L, _ = hq.shape
    lb = lb.astype(jnp.float32)
    log_f = jnp.logaddexp(jnp.log(lb), jnp.log1p(-lb) + jax.nn.log_sigmoid(hf.astype(jnp.float32)))
    k = -jnp.expm1(log_f)
    q = jax.nn.silu(hq.astype(jnp.float32))
    o = hgrn2_chunk_scan(q.reshape(B, L, HG_HEADS, HG_K), k.reshape(B, L, HG_HEADS, HG_K),
                         hi.reshape(B, L, HG_HEADS, HG_V), log_f.reshape(B, L, HG_HEADS, HG_K))
    o = rmsnorm(o, out_gain) * jax.nn.silu(hg.reshape(B, L, HG_HEADS, HG_V).astype(jnp.float32))
    return o.reshape(B, L, HG_VW).astype(hq.dtype)


def block_causal_attention(q, k, v, cid):
    B, L, H, Dq = q.shape
    nq = -(-L // Q_BLOCK)
    pad = nq * Q_BLOCK - L
    qp = jnp.pad(q, ((0, 0), (0, pad), (0, 0), (0, 0)))
    qb = qp.reshape(B, nq, Q_BLOCK, H, Dq).transpose(1, 0, 2, 3, 4)
    qcid = jnp.pad(cid, (0, pad), constant_values=L).reshape(nq, Q_BLOCK)
    scale = Dq ** -0.5

    def one_block(args):
        qblk, qc = args
        s = jnp.einsum('bqhd,bkhd->bhqk', qblk, k).astype(jnp.float32) * scale
        mask = cid[None, :] <= qc[:, None]
        p = jax.nn.softmax(jnp.where(mask, s, -jnp.inf), axis=-1).astype(v.dtype)
        return jnp.einsum('bhqk,bkhd->bqhd', p, v)

    out = lax.map(one_block, (qb, qcid))
    out = out.transpose(1, 0, 2, 3, 4).reshape(B, nq * Q_BLOCK, H, v.shape[-1])
    return out[:, :L]


def mla_mixer(cq, ckv, kr, qa_g, kva_g, w_q_up, w_kv_up, qn_g, kn_g, cos, sin, cid):
    B, L, _ = cq.shape
    q = jnp.einsum('blr,re->ble', rmsnorm(cq, qa_g), w_q_up).reshape(B, L, MLA_HEADS, QK_DIM)
    kv = jnp.einsum('blr,re->ble', rmsnorm(ckv, kva_g), w_kv_up).reshape(B, L, MLA_HEADS, NOPE + V_DIM)
    k_nope, v = kv[..., :NOPE], kv[..., NOPE:]
    k = jnp.concatenate([k_nope, jnp.broadcast_to(kr[:, :, None, :], (B, L, MLA_HEADS, ROPE))], axis=-1)
    q = rope_tail(rmsnorm(q, qn_g), cos, sin)
    k = rope_tail(rmsnorm(k, kn_g), cos, sin)
    o = block_causal_attention(q, k, v, cid)
    return o.reshape(B, L, MLA_HEADS * V_DIM)


def multiscale_pool(h, w_groups, scale):
    B, L, D = h.shape
    hf = h.astype(jnp.float32).reshape(B, L, POOL_GROUPS, POOL_G)
    t = jnp.arange(L, dtype=jnp.float32)
    diffs = []
    for gi, w in enumerate(POOL_WINDOWS):
        c = jnp.pad(jnp.cumsum(hf[:, :, gi], axis=1), ((0, 0), (w, 0), (0, 0)))
        win = c[:, w:] - c[:, :L]
        cnt = jnp.minimum(t + 1.0, float(w))[None, :, None]
        diffs.append(win / cnt - hf[:, :, gi])
    d = jnp.stack(diffs, axis=2).astype(h.dtype)
    y = jnp.einsum('blgc,gce->blge', d, w_groups).reshape(B, L, D)
    return y * scale


def squared_relu_mlp(h, w_up, w_down):
    a = jax.nn.relu(jnp.einsum('bld,df->blf', h, w_up))
    return jnp.einsum('blf,fd->bld', a * a, w_down)


def setup_inputs(seed: int = 0) -> dict:
    key = jax.random.key(seed)
    ks = jax.random.split(key, 20)
    n = jax.random.normal
    f32 = jnp.float32
    return {
        'x': n(ks[0], (BATCH, SEQ, D_MODEL), f32),
        'meta_tokens': n(ks[1], (N_META, D_MODEL), f32),
        'mix_norm': 1.0 + 0.02 * n(ks[2], (DEPTH, D_MODEL), f32),
        'mlp_norm': 1.0 + 0.02 * n(ks[3], (DEPTH, D_MODEL), f32),
        'w_mlp_up': n(ks[4], (DEPTH, D_MODEL, D_FF), f32) * D_MODEL ** -0.5,
        'w_mlp_down': n(ks[5], (DEPTH, D_FF, D_MODEL), f32) * (0.5 * D_FF ** -0.5),
        'w_in': n(ks[6], (N_EVEN, D_MODEL, IN_COLS), f32) * D_MODEL ** -0.5,
        'hgrn_lb': 0.5 * n(ks[7], (N_EVEN, HG_KW), f32),
        'hgrn_out_norm': 1.0 + 0.02 * n(ks[8], (N_EVEN, HG_V), f32),
        'mla_q_a_norm': 1.0 + 0.02 * n(ks[9], (N_EVEN, Q_RANK), f32),
        'mla_kv_a_norm': 1.0 + 0.02 * n(ks[10], (N_EVEN, KV_RANK), f32),
        'w_q_up': n(ks[11], (N_EVEN, Q_RANK, MLA_HEADS * QK_DIM), f32) * Q_RANK ** -0.5,
        'w_kv_up': n(ks[12], (N_EVEN, KV_RANK, MLA_HEADS * (NOPE + V_DIM)), f32) * KV_RANK ** -0.5,
        'q_norm': 1.0 + 0.02 * n(ks[13], (N_EVEN, QK_DIM), f32),
        'k_norm': 1.0 + 0.02 * n(ks[14], (N_EVEN, QK_DIM), f32),
        'w_out': n(ks[15], (N_EVEN, HG_VW + MLA_HEADS * V_DIM, D_MODEL), f32) * D_MODEL ** -0.5,
        'pool_w': n(ks[16], (N_ODD, POOL_GROUPS, POOL_G, POOL_G), f32) * POOL_G ** -0.5,
        'pool_scale': 1.0 + 0.1 * n(ks[17], (N_ODD, D_MODEL), f32),
    }


def reference(x, meta_tokens, mix_norm, mlp_norm, w_mlp_up, w_mlp_down, w_in, hgrn_lb,
              hgrn_out_norm, mla_q_a_norm, mla_kv_a_norm, w_q_up, w_kv_up, q_norm, k_norm,
              w_out, pool_w, pool_scale):
    B = x.shape[0]
    meta = jnp.broadcast_to(meta_tokens[None].astype(x.dtype), (B, N_META, D_MODEL))
    h = jnp.concatenate([meta, x], axis=1)
    L = h.shape[1]
    cid = chunk_ids(L)
    cos, sin = rope_tables(L)
    lb_cum = jnp.cumsum(jax.nn.softmax(hgrn_lb.astype(jnp.float32), axis=0), axis=0)
    lower_bounds = lb_cum - lb_cum[0:1]

    for layer in range(DEPTH):
        u = rmsnorm(h, mix_norm[layer])
        if layer % 2 == 0:
            e = layer // 2
            z = jnp.einsum('bld,de->ble', u, w_in[e])
            hq, hf, hi, hg, cq, ckv, kr = jnp.split(z, IN_SPLITS, axis=-1)
            o_a = hgrn2_mixer(hq, hf, hi, hg, lower_bounds[e], hgrn_out_norm[e])
            o_b = mla_mixer(cq, ckv, kr, mla_q_a_norm[e], mla_kv_a_norm[e], w_q_up[e], w_kv_up[e],
                            q_norm[e], k_norm[e], cos, sin, cid)
            mix = jnp.einsum('ble,ed->bld', jnp.concatenate([o_a, o_b], axis=-1), w_out[e])
        else:
            o = layer // 2
            mix = multiscale_pool(u, pool_w[o], pool_scale[o])
        h = h + mix
        h = h + squared_relu_mlp(rmsnorm(h, mlp_norm[layer]), w_mlp_up[layer], w_mlp_down[layer])

    return h[:, N_META:]
```

```cpp
#include <hip/hip_runtime.h>
#include <hip/hip_cooperative_groups.h>
#include <cstdio>
#include <cstdint>
#include <cmath>
namespace cg = cooperative_groups;

#define LAS __attribute__((address_space(3)))
#define DI __device__ __forceinline__
typedef unsigned short bf16_t;
typedef short bf16x8 __attribute__((ext_vector_type(8)));
typedef float f32x2 __attribute__((ext_vector_type(2)));
typedef float f32x4 __attribute__((ext_vector_type(4)));
typedef float f32x16 __attribute__((ext_vector_type(16)));
typedef unsigned u32x2 __attribute__((ext_vector_type(2)));
typedef unsigned u32x4 __attribute__((ext_vector_type(4)));
typedef __bf16 bf16v2 __attribute__((ext_vector_type(2)));

constexpr int DM = 1024, NB = 2, SEQ = 16384, NMETA = 16, LSEQ = SEQ + NMETA;
constexpr int LP = 16448;
constexpr int NCH = 257;
constexpr int MR = NB * LP;
constexpr int MT = 33024;
constexpr int DFF = 4096;
constexpr int INC = 2624, INP = 2816;
constexpr float EPS = 1e-6f;
constexpr float NEG_INF = -INFINITY;

constexpr size_t OFF_WUP = 0;
constexpr size_t OFF_WDN = OFF_WUP + (size_t)DFF * DM * 2;
constexpr size_t OFF_WIN = OFF_WDN + (size_t)DFF * DM * 2;
constexpr size_t OFF_WQ = OFF_WIN + (size_t)INP * DM * 2;
constexpr size_t OFF_WKN = OFF_WQ + (size_t)768 * 256 * 2;
constexpr size_t OFF_WV = OFF_WKN + (size_t)512 * 256 * 2;
constexpr size_t OFF_WOUT = OFF_WV + (size_t)512 * 256 * 2;
constexpr size_t OFF_WPOOL = OFF_WOUT + (size_t)DM * DM * 2;
constexpr size_t OFF_COS = OFF_WPOOL + (size_t)4 * 256 * 256 * 2;
constexpr size_t OFF_SIN = OFF_COS + (size_t)LSEQ * 32 * 4;
constexpr size_t OFF_LB = OFF_SIN + (size_t)LSEQ * 32 * 4;
constexpr size_t OFF_HSIDE = OFF_LB + 4 * 512 * 4;
constexpr size_t OFF_SSQQ = OFF_HSIDE + (size_t)2 * 16 * 1024 * 4;
constexpr size_t OFF_SSQKV = OFF_SSQQ + (size_t)MT * 4 * 4;
constexpr size_t OFF_DEC = OFF_SSQKV + (size_t)MT * 4 * 4;
constexpr size_t OFF_SSQH = OFF_DEC + (size_t)514 * 512 * 4;
constexpr size_t OFF_U = ((OFF_SSQH + (size_t)MT * 16 * 4 + 4095) / 4096) * 4096;
constexpr size_t OFF_BIG = OFF_U + (size_t)MT * 1024 * 2;
constexpr size_t B_QH = 0;
constexpr size_t B_VH = B_QH + (size_t)MT * 512 * 2;
constexpr size_t B_GT = B_VH + (size_t)MT * 512 * 2;
constexpr size_t B_LOGF = B_GT + (size_t)MT * 512 * 2;
constexpr size_t B_CQ = B_LOGF + (size_t)MT * 512 * 4;
constexpr size_t B_CKV = B_CQ + (size_t)MT * 256 * 2;
constexpr size_t B_KR = B_CKV + (size_t)MT * 256 * 2;
constexpr size_t B_QP = B_KR + (size_t)MT * 64 * 2;
constexpr size_t B_KK = B_QP + (size_t)MT * 768 * 2;
constexpr size_t B_VT = B_KK + (size_t)MT * 768 * 2;
constexpr size_t B_ST = B_VT + (size_t)NB * 4 * 128 * LP * 2;
constexpr size_t B_END = B_ST + (size_t)514 * 4 * 128 * 128 * 2;
constexpr size_t B_HB = (size_t)300 << 20;
static_assert(B_HB >= (size_t)MT * DFF * 2 && B_HB + (size_t)MT * 1024 * 2 <= B_END, "HB placement");
constexpr size_t OFF_CTL = OFF_BIG + B_END;
constexpr size_t CTL_BYTES = 16384;
constexpr size_t WS_NEED = OFF_CTL + CTL_BYTES;
static_assert(WS_NEED <= 536870912ull, "workspace");
static_assert((size_t)MT * DFF * 2 <= B_END, "A2 fits");
constexpr int LDS_BYTES = 147456;

struct Params {
  const float *x, *meta, *mix_norm, *mlp_norm, *w_mlp_up, *w_mlp_down, *w_in, *hgrn_lb, *hgrn_out_norm, *qa_norm, *kva_norm,
      *w_q_up, *w_kv_up, *q_norm, *k_norm, *w_out, *pool_w, *pool_scale;
  float* out; unsigned char* ws;
};
__constant__ double INVF[32] = {1.0, 0.7498942093324559, 0.5623413251903491, 0.4216965034285822, 0.31622776601683794, 0.23713737056616552, 0.1778279410038923, 0.1333521432163324, 0.1, 0.07498942093324558, 0.05623413251903491, 0.042169650342858224, 0.03162277660168379, 0.023713737056616554, 0.01778279410038923, 0.01333521432163324, 0.01, 0.007498942093324558, 0.005623413251903491, 0.004216965034285823, 0.0031622776601683794, 0.0023713737056616554, 0.0017782794100389228, 0.001333521432163324, 0.001, 0.0007498942093324559, 0.0005623413251903491, 0.00042169650342858224, 0.00031622776601683794, 0.00023713737056616554, 0.00017782794100389227, 0.0001333521432163324};

typedef const __attribute__((address_space(4))) struct Params* KP;
DI KP kparams() { const __attribute__((address_space(4))) unsigned char* p = (const __attribute__((address_space(4))) unsigned char*)__builtin_amdgcn_kernarg_segment_ptr(); asm volatile("" : "+s"(p)); return (KP)p; }
DI int obid() { int t = blockIdx.x; asm volatile("" : "+s"(t)); return t; }
DI int ogrid() { int t = gridDim.x; asm volatile("" : "+s"(t)); return t; }
DI float ozero() { float z = 0.f; asm volatile("" : "+v"(z)); return z; }
DI unsigned ouz() { unsigned z = 0u; asm volatile("" : "+v"(z)); return z; }
DI int otid() { int t = threadIdx.x; asm volatile("" : "+v"(t)); return t; }
DI unsigned char* opq(unsigned char* p) { asm volatile("" : "+s"(p)); return p; }
DI unsigned pk2(float lo, float hi) { f32x2 f = {lo, hi}; bf16v2 b = __builtin_convertvector(f, bf16v2); return __builtin_bit_cast(unsigned, b); }
DI float bflo(unsigned w) { return __uint_as_float(w << 16); }
DI float bfhi(unsigned w) { return __uint_as_float(w & 0xffff0000u); }
DI float bf2f(bf16_t v) { return __uint_as_float(((unsigned)v) << 16); }
DI float fexp(float x) { return __builtin_amdgcn_exp2f(x * 1.44269504088896f); }
DI float flog(float x) { return __builtin_amdgcn_logf(x) * 0.69314718055994f; }
DI float silu(float x) { return x * __builtin_amdgcn_rcpf(1.0f + fexp(-x)); }
DI float wave_sum(float v) {
#pragma unroll
  for (int o = 1; o < 64; o <<= 1) v += __shfl_xor(v, o);
  return v;
}
DI bool row_is_pad(int r) { if (r >= MR) return true; const int pp = r >= LP ? r - LP : r; return pp < 48; }
struct HMap { const float* real; const float* side; int sb; const bf16_t* b16; };
DI bool row_is_main(int r) { if (r >= 32768) return false; const int pp = r >= LP ? r - LP : r; return pp >= 64; }
DI size_t main_off(int r) { return (size_t)r * 1024; }
DI const float* hptr(const HMap& m, int r) { const int b = r >= LP ? 1 : 0; const int pp = r - b * LP;
  return pp < 64 ? m.side + ((size_t)b * m.sb + (size_t)(pp - 48) * 1024) : m.real + ((size_t)(b * SEQ + pp - 64)) * 1024; }
#define MFMA32(a, b, c) __builtin_amdgcn_mfma_f32_32x32x16_bf16((a), (b), (c), 0, 0, 0)
DI int perm32k(int i) { return (i & 0x13) | ((i & 8) >> 1) | ((i & 4) << 1); }
DI bf16x8 pack8(const f32x16& x, int s) { u32x4 p; p.x = pk2(x[8 * s], x[8 * s + 1]); p.y = pk2(x[8 * s + 2], x[8 * s + 3]); p.z = pk2(x[8 * s + 4], x[8 * s + 5]); p.w = pk2(x[8 * s + 6], x[8 * s + 7]); return __builtin_bit_cast(bf16x8, p); }

namespace pg8 {
constexpr int BM = 256, BK = 64, HALF = 128, HTB = HALF * BK * 2, STAGE_BYTES = 8 * HTB, NXCD = 8, WGM = 8;
DI int lds_byte(int r, int c) { const int st = (r >> 4) * 2 + (c >> 5), rr = r & 15, cc = c & 31, ob = rr * 64 + cc * 2; return st * 1024 + (ob ^ (((ob >> 9) & 1) << 5)); }
DI void stage_rc(int b, int& R, int& C) { const int st = b / 1024, sb = b % 1024, swz = sb ^ (((sb >> 9) & 1) << 5); R = (st >> 1) * 16 + swz / 64; C = (st & 1) * 32 + (swz % 64) / 2; }
DI int perm32(int rho) { const int n = rho >> 4, i = rho & 15; return 8 * (i >> 2) + 4 * n + (i & 3); }
struct Unit { int pm, pn; unsigned kb; };
struct Gemm { const bf16_t* A; const bf16_t* Bt; int M, N, K, lda, ldb; };
struct StaticOrder {
  int nM, nN, nwg, G, c, rev;
  DI void init(int M, int N, int G_, int c_, int rot, int rev_ = 0) { nM = M / BM; nN = N / BM; nwg = nM * nN; G = G_; c = (c_ + rot) % G_; rev = rev_; }
  DI bool next(int i, Unit& u) const {
    const long L = (long)i * G + c; if (L >= nwg) return false;
    int wgid = (int)L; { const int q = nwg / NXCD, r = nwg % NXCD, xcd = wgid % NXCD, off = wgid / NXCD; wgid = (xcd < r ? xcd * (q + 1) : r * (q + 1) + (xcd - r) * q) + off; }
    const int nig = WGM * nN, gid = wgid / nig, fm = gid * WGM, gsz = (nM - fm) < WGM ? (nM - fm) : WGM;
    u.pm = fm + ((wgid % nig) % gsz); if (rev) u.pm = nM - 1 - u.pm; u.pn = (wgid % nig) / gsz; u.kb = 0u; return true;
  }
};
struct SplitOrder {
  int nN, total, G, c; unsigned kbytes;
  DI void init(int nN_, int ksplit, unsigned kbytes_, int G_, int c_, int rot) { nN = nN_; total = nN_ * ksplit; kbytes = kbytes_; G = G_; c = (c_ + rot) % G_; }
  DI bool next(int i, Unit& u) const { const int L = i * G + c; if (L >= total) return false; u.pm = 0; u.pn = L % nN; u.kb = (unsigned)(L / nN) * kbytes; return true; }
};
template <class Epi, class Sched>
DI void gemm_phase(LAS unsigned char* lds, const Gemm g, const Sched& S, const Epi& E) {
  const int tid = otid(), wid = __builtin_amdgcn_readfirstlane(tid >> 6), lane = tid & 63, wr = wid >> 2, wc = wid & 3, fr = lane & 15, fq = lane >> 4;
  const int K = g.K, nt = K / BK;
  unsigned voffA[2], voffB[2];
#pragma unroll
  for (int i = 0; i < 2; ++i) { int R, C; stage_rc(tid * 16 + i * 8192, R, C); const int Rb = Epi::PERM ? ((R & ~31) + perm32(R & 31)) : R;
    voffA[i] = (unsigned)(R * g.lda + C) * 2u; voffB[i] = (unsigned)(Rb * g.ldb + C) * 2u; }
  constexpr unsigned kstep = BK * 2;
  const unsigned hstepA = (unsigned)HALF * g.lda * 2u, hstepB = (unsigned)HALF * g.ldb * 2u;
#define tstepA (2 * (size_t)hstepA)
#define tstepB (2 * (size_t)hstepB)
  const unsigned ldsw = (unsigned)wid * 1024u;
  const int aoff = lds_byte(wr * 64 + fr, fq * 8), boff = lds_byte(wc * 32 + fr, fq * 8);
#define PG8_SA(b, h) (((b) * 2 + (h)) * HTB)
#define PG8_SB(b, h) ((4 + (b) * 2 + (h)) * HTB)
#define PG8_STAGE(bufoff, gbase, voff) do { _Pragma("unroll") for (int _i = 0; _i < 2; ++_i) \
        __builtin_amdgcn_global_load_lds((const unsigned*)((const char*)(gbase) + (voff)[_i]), (LAS unsigned*)(lds + (bufoff) + ldsw + _i * 8192), 16, 0, 0); } while (0)
#define PG8_LDA(dst, b, h) do { _Pragma("unroll") for (int m = 0; m < 4; ++m) _Pragma("unroll") for (int k = 0; k < 2; ++k) dst[m][k] = *(const LAS bf16x8*)(lds + PG8_SA(b, h) + aoff + m * 2048 + k * 1024); } while (0)
#define PG8_LDB(dst, b, h) do { _Pragma("unroll") for (int n = 0; n < 2; ++n) _Pragma("unroll") for (int k = 0; k < 2; ++k) dst[n][k] = *(const LAS bf16x8*)(lds + PG8_SB(b, h) + boff + n * 2048 + k * 1024); } while (0)
#define PG8_MMA(ai, bj, At, Bt) do { __builtin_amdgcn_s_setprio(1); _Pragma("unroll") for (int m = 0; m < 4; ++m) _Pragma("unroll") for (int n = 0; n < 2; ++n) _Pragma("unroll") for (int k = 0; k < 2; ++k) \
        acc[ai][bj][m][n] = __builtin_amdgcn_mfma_f32_16x16x32_bf16(Bt[n][k], At[m][k], acc[ai][bj][m][n], 0, 0, 0); __builtin_amdgcn_s_setprio(0); } while (0)
#define PG8_WAIT_V(n) asm volatile("s_waitcnt vmcnt(" #n ")" ::: "memory")
#define PG8_WAIT_L(n) asm volatile("s_waitcnt lgkmcnt(" #n ")" ::: "memory")
#define PG8_BAR __builtin_amdgcn_s_barrier()
#define PG8_SCHED __builtin_amdgcn_sched_barrier(0)
  Unit cur, nxt; int ui = 0;
  if (!S.next(0, cur)) return;
  f32x4 acc[2][2][4][2];
  { const float z0 = ozero();
#pragma unroll
  for (int a = 0; a < 2; ++a)
#pragma unroll
    for (int b = 0; b < 2; ++b)
#pragma unroll
      for (int m = 0; m < 4; ++m)
#pragma unroll
        for (int n = 0; n < 2; ++n) acc[a][b][m][n] = (f32x4){z0, z0, z0, z0}; }
  bf16x8 At[4][2], B0[2][2], B1[2][2];
  const char* cA = (const char*)g.A + (size_t)cur.pm * tstepA + cur.kb; const char* cB = (const char*)g.Bt + (size_t)cur.pn * tstepB + cur.kb;
  PG8_STAGE(PG8_SB(0, 0), cB, voffB); PG8_STAGE(PG8_SB(0, 1), cB + hstepB, voffB); PG8_STAGE(PG8_SA(0, 0), cA, voffA); PG8_STAGE(PG8_SA(0, 1), cA + hstepA, voffA);
  if (wr == 1) PG8_BAR;
  PG8_WAIT_V(2); PG8_BAR;
  PG8_STAGE(PG8_SB(1, 0), cB + kstep, voffB); PG8_STAGE(PG8_SA(1, 0), cA + kstep, voffA); PG8_STAGE(PG8_SB(1, 1), cB + hstepB + kstep, voffB);
  PG8_WAIT_V(6); PG8_BAR;
  for (;;) {
    const bool has_next = S.next(ui + 1, nxt);
    const char* nA = has_next ? (const char*)g.A + (size_t)nxt.pm * tstepA + nxt.kb : cA; const char* nB = has_next ? (const char*)g.Bt + (size_t)nxt.pn * tstepB + nxt.kb : cB;
    for (int t = 0; t < nt; t += 2) {
      const bool last = (t == nt - 2);
      const char* a1 = cA + (size_t)(t + 1) * kstep;
      const char* a2 = last ? nA : cA + (size_t)(t + 2) * kstep; const char* b2 = last ? nB : cB + (size_t)(t + 2) * kstep;
      const char* a3 = a2 + kstep; const char* b3 = b2 + kstep;
      PG8_LDB(B0, 0, 0); PG8_LDB(B1, 0, 1); PG8_SCHED; PG8_LDA(At, 0, 0); PG8_STAGE(PG8_SA(1, 1), a1 + hstepA, voffA);
      PG8_WAIT_V(8); PG8_WAIT_L(0); PG8_BAR; PG8_MMA(0, 0, At, B0); PG8_MMA(0, 1, At, B1); PG8_BAR; PG8_SCHED;
      PG8_LDA(At, 0, 1); PG8_STAGE(PG8_SB(0, 0), b2, voffB); PG8_STAGE(PG8_SB(0, 1), b2 + hstepB, voffB); PG8_STAGE(PG8_SA(0, 0), a2, voffA);
      PG8_WAIT_V(8); PG8_WAIT_L(0); PG8_BAR; PG8_MMA(1, 0, At, B0); PG8_MMA(1, 1, At, B1); PG8_BAR; PG8_SCHED;
      PG8_LDB(B0, 1, 0); PG8_LDB(B1, 1, 1); PG8_SCHED; PG8_LDA(At, 1, 0); PG8_STAGE(PG8_SA(0, 1), a2 + hstepA, voffA);
      PG8_WAIT_V(8); PG8_WAIT_L(0); PG8_BAR; PG8_MMA(0, 0, At, B0); PG8_MMA(0, 1, At, B1); PG8_BAR; PG8_SCHED;
      PG8_LDA(At, 1, 1); PG8_STAGE(PG8_SB(1, 0), b3, voffB); PG8_STAGE(PG8_SB(1, 1), b3 + hstepB, voffB); PG8_STAGE(PG8_SA(1, 0), a3, voffA);
      PG8_WAIT_V(8); PG8_WAIT_L(0); PG8_BAR; PG8_MMA(1, 0, At, B0); PG8_MMA(1, 1, At, B1); PG8_BAR; PG8_SCHED;
    }
    if (wr == 0) PG8_BAR;
    { const int l2 = otid() & 63; E(acc, cur, wr, wc, l2 & 15, l2 >> 4); }
    if (!has_next) break;
    { const float z0 = ozero();
#pragma unroll
    for (int a = 0; a < 2; ++a)
#pragma unroll
      for (int b = 0; b < 2; ++b)
#pragma unroll
        for (int m = 0; m < 4; ++m)
#pragma unroll
          for (int n = 0; n < 2; ++n) acc[a][b][m][n] = (f32x4){z0, z0, z0, z0}; }
    cur = nxt; cA = nA; cB = nB; ++ui;
    if (wr == 1) PG8_BAR;
  }
  PG8_WAIT_V(0);
  PG8_BAR;
#undef tstepA
#undef tstepB
#undef PG8_SA
#undef PG8_SB
#undef PG8_STAGE
#undef PG8_LDA
#undef PG8_LDB
#undef PG8_MMA
#undef PG8_WAIT_V
#undef PG8_WAIT_L
#undef PG8_BAR
#undef PG8_SCHED
}
}
using pg8::Unit;
typedef const f32x4 (&AccRef)[2][2][4][2];

DI u32x4 pack_v8(f32x4 v0, f32x4 v1) { u32x4 w; w.x = pk2(v0[0], v0[1]); w.y = pk2(v0[2], v0[3]); w.z = pk2(v1[0], v1[1]); w.w = pk2(v1[2], v1[3]); return w; }

DI float rstd16(const float* ssq, int row);
struct EpiIn {
  static constexpr bool PERM = true;
  unsigned char* big; unsigned char* wsb; int e; const float* rs16;
  DI void operator()(AccRef acc, const Unit& u, int wr, int wc, int fr, int fq) const {
    bf16_t* const QH = (bf16_t*)(big + B_QH); bf16_t* const VH = (bf16_t*)(big + B_VH); bf16_t* const GT = (bf16_t*)(big + B_GT); bf16_t* const CQ = (bf16_t*)(big + B_CQ);
    bf16_t* const CKV = (bf16_t*)(big + B_CKV); bf16_t* const KR = (bf16_t*)(big + B_KR); float* const LOGF = (float*)(big + B_LOGF);
    float* const SSQQ = (float*)(wsb + OFF_SSQQ); float* const SSQKV = (float*)(wsb + OFF_SSQKV); const float* const ll = (const float*)(wsb + OFF_LB) + e * 512; const float* const l1m = ll + 1024;
    const int pn = u.pn; const int rowb = u.pm * 256 + wr * 64 + fr; const int cw = wc * 32 + 8 * fq;
    if (pn < 2 || (pn >= 4 && pn < 8)) {
      bf16_t* base = pn < 2 ? QH : (pn < 6 ? VH : GT); const bool act = (pn < 2) || (pn >= 6); const int cb = (pn & 1) * 256 + cw;
#pragma unroll
      for (int ai = 0; ai < 2; ++ai)
#pragma unroll
        for (int m = 0; m < 4; ++m) { const int row = rowb + ai * 128 + m * 16; const float rs = rs16 ? rstd16(rs16, row) : 1.0f;
#pragma unroll
          for (int bj = 0; bj < 2; ++bj) { f32x4 v0 = acc[ai][bj][m][0] * rs, v1 = acc[ai][bj][m][1] * rs;
            if (act) {
#pragma unroll
              for (int j = 0; j < 4; ++j) { v0[j] = silu(v0[j]); v1[j] = silu(v1[j]); } }
            *(u32x4*)(base + (size_t)row * 512 + cb + bj * 128) = pack_v8(v0, v1); } }
    } else if (pn < 4) {
#pragma unroll
      for (int bj = 0; bj < 2; ++bj) { const int cb = (pn - 2) * 256 + bj * 128 + cw;
        f32x4 la0 = *(const f32x4*)(ll + cb), la1 = *(const f32x4*)(ll + cb + 4), lm0 = *(const f32x4*)(l1m + cb), lm1 = *(const f32x4*)(l1m + cb + 4);
#pragma unroll
        for (int ai = 0; ai < 2; ++ai)
#pragma unroll
          for (int m = 0; m < 4; ++m) { const int row = rowb + ai * 128 + m * 16; const bool pad = row_is_pad(row); const float rs = rs16 ? rstd16(rs16, row) : 1.0f;
            f32x4 o0, o1;
#pragma unroll
            for (int j = 0; j < 4; ++j) {
              { const float z = acc[ai][bj][m][0][j] * rs; const float ls = fminf(z, 0.f) - flog(1.0f + fexp(-fabsf(z))); const float c = lm0[j] + ls, a = la0[j];
                const float mx = fmaxf(a, c); o0[j] = pad ? 0.f : mx + flog(1.0f + fexp(-fabsf(a - c))); }
              { const float z = acc[ai][bj][m][1][j] * rs; const float ls = fminf(z, 0.f) - flog(1.0f + fexp(-fabsf(z))); const float c = lm1[j] + ls, a = la1[j];
                const float mx = fmaxf(a, c); o1[j] = pad ? 0.f : mx + flog(1.0f + fexp(-fabsf(a - c))); } }
            typedef _Float16 h16x8 __attribute__((ext_vector_type(8)));
            h16x8 hv; hv[0] = (_Float16)o0[0]; hv[1] = (_Float16)o0[1]; hv[2] = (_Float16)o0[2]; hv[3] = (_Float16)o0[3]; hv[4] = (_Float16)o1[0]; hv[5] = (_Float16)o1[1]; hv[6] = (_Float16)o1[2]; hv[7] = (_Float16)o1[3];
            *(h16x8*)((_Float16*)LOGF + (size_t)row * 512 + cb) = hv; } }
    } else if (pn < 10) {
      bf16_t* base = pn == 8 ? CQ : CKV; float* ssq = pn == 8 ? SSQQ : SSQKV;
#pragma unroll
      for (int ai = 0; ai < 2; ++ai)
#pragma unroll
        for (int m = 0; m < 4; ++m) { const int row = rowb + ai * 128 + m * 16; float s = 0.f; const float rs = rs16 ? rstd16(rs16, row) : 1.0f;
#pragma unroll
          for (int bj = 0; bj < 2; ++bj) { const f32x4 v0 = acc[ai][bj][m][0] * rs, v1 = acc[ai][bj][m][1] * rs;
            s += (v0[0] * v0[0] + v0[1] * v0[1]) + (v0[2] * v0[2] + v0[3] * v0[3]) + (v1[0] * v1[0] + v1[1] * v1[1]) + (v1[2] * v1[2] + v1[3] * v1[3]);
            *(u32x4*)(base + (size_t)row * 256 + cw + bj * 128) = pack_v8(v0, v1); }
          s += __shfl_xor(s, 16); s += __shfl_xor(s, 32);
          if (fq == 0) ssq[(size_t)row * 4 + wc] = s; }
    } else {
      if (wc < 2) {
#pragma unroll
        for (int ai = 0; ai < 2; ++ai)
#pragma unroll
          for (int m = 0; m < 4; ++m) { const int row = rowb + ai * 128 + m * 16; const float rs = rs16 ? rstd16(rs16, row) : 1.0f;
            *(u32x4*)(KR + (size_t)row * 64 + cw) = pack_v8(acc[ai][0][m][0] * rs, acc[ai][0][m][1] * rs); } }
    }
  }
};
DI float rstd4(const float* ssq, int row, float invn) { const f32x4 s = *(const f32x4*)(ssq + (size_t)row * 4); return __builtin_amdgcn_rsqf(((s[0] + s[1]) + (s[2] + s[3])) * invn + EPS); }
DI float rstd16(const float* ssq, int row) { const f32x4* p = (const f32x4*)(ssq + (size_t)row * 16); const f32x4 a = p[0], b = p[1], c = p[2], d = p[3];
  return __builtin_amdgcn_rsqf((((a[0] + a[1]) + (a[2] + a[3])) + ((b[0] + b[1]) + (b[2] + b[3])) + ((c[0] + c[1]) + (c[2] + c[3])) + ((d[0] + d[1]) + (d[2] + d[3]))) * (1.0f / 1024.0f) + EPS); }
struct EpiQ {
  static constexpr bool PERM = true; bf16_t* QP; const float* ssq;
  DI void operator()(AccRef acc, const Unit& u, int wr, int wc, int fr, int fq) const {
    const int rowb = u.pm * 256 + wr * 64 + fr; const int cb = u.pn * 256 + wc * 32 + 8 * fq;
#pragma unroll
    for (int ai = 0; ai < 2; ++ai)
#pragma unroll
      for (int m = 0; m < 4; ++m) { const int row = rowb + ai * 128 + m * 16; const float rs = rstd4(ssq, row, 1.0f / 256.0f);
#pragma unroll
        for (int bj = 0; bj < 2; ++bj) *(u32x4*)(QP + (size_t)row * 768 + cb + bj * 128) = pack_v8(acc[ai][bj][m][0] * rs, acc[ai][bj][m][1] * rs); }
  }
};
struct EpiKn {
  static constexpr bool PERM = true; bf16_t* KK; const float* ssq;
  DI void operator()(AccRef acc, const Unit& u, int wr, int wc, int fr, int fq) const {
    const int rowb = u.pm * 256 + wr * 64 + fr; const int d0 = wc * 32 + 8 * fq;
#pragma unroll
    for (int ai = 0; ai < 2; ++ai)
#pragma unroll
      for (int m = 0; m < 4; ++m) { const int row = rowb + ai * 128 + m * 16; const float rs = rstd4(ssq, row, 1.0f / 256.0f);
#pragma unroll
        for (int bj = 0; bj < 2; ++bj) *(u32x4*)(KK + (size_t)row * 768 + (u.pn * 2 + bj) * 192 + d0) = pack_v8(acc[ai][bj][m][0] * rs, acc[ai][bj][m][1] * rs); }
  }
};
struct EpiVt {
  static constexpr bool PERM = true; bf16_t* VT; const float* ssq;
  DI void operator()(AccRef acc, const Unit& u, int wr, int wc, int fr, int fq) const {
    const int fb = u.pm * 256 + wr * 64 + fr;
#pragma unroll
    for (int bj = 0; bj < 2; ++bj) { const int t0 = u.pn * 256 + bj * 128 + wc * 32 + 8 * fq;
      if (t0 >= MR) continue;
      float rs[8];
#pragma unroll
      for (int j = 0; j < 8; ++j) rs[j] = rstd4(ssq, t0 + j, 1.0f / 256.0f);
      const int b = t0 >= LP ? 1 : 0; const int pp = t0 - b * LP;
#pragma unroll
      for (int ai = 0; ai < 2; ++ai)
#pragma unroll
        for (int m = 0; m < 4; ++m) { const int f = fb + ai * 128 + m * 16; const int hd = f >> 7, d = f & 127;
          f32x4 v0 = acc[ai][bj][m][0], v1 = acc[ai][bj][m][1];
#pragma unroll
          for (int j = 0; j < 4; ++j) { v0[j] *= rs[j]; v1[j] *= rs[4 + j]; }
          *(u32x4*)(VT + ((size_t)((b * 4 + hd) * 128 + d)) * LP + pp) = pack_v8(v0, v1); } }
  }
};
struct EpiUp {
  static constexpr bool PERM = true; bf16_t* A2; const float* SSQH;
  DI void operator()(AccRef acc, const Unit& u, int wr, int wc, int fr, int fq) const {
    const int rowb = u.pm * 256 + wr * 64 + fr; const int cb = u.pn * 256 + wc * 32 + 8 * fq;
#pragma unroll
    for (int ai = 0; ai < 2; ++ai)
#pragma unroll
      for (int m = 0; m < 4; ++m) { const int row = rowb + ai * 128 + m * 16; const float rs = rstd16(SSQH, row);
#pragma unroll
        for (int bj = 0; bj < 2; ++bj) { f32x4 v0 = acc[ai][bj][m][0], v1 = acc[ai][bj][m][1];
#pragma unroll
          for (int j = 0; j < 4; ++j) { const float a = fmaxf(v0[j], 0.f) * rs, b = fmaxf(v1[j], 0.f) * rs; v0[j] = a * a; v1[j] = b * b; }
          *(u32x4*)(A2 + (size_t)row * DFF + cb + bj * 128) = pack_v8(v0, v1); } }
  }
};
struct EpiRes {
  static constexpr bool PERM = true; HMap in; HMap outm; const float* scale; int coff; bf16_t* HB; float* SSQH; int wmode;
  DI void operator()(AccRef acc, const Unit& u, int wr, int wc, int fr, int fq) const {
    const bool w32 = (wmode == 1) || (wmode == 2 && u.pm == 128);
    const int rowb = u.pm * 256 + wr * 64 + fr; const int cb = coff + u.pn * 256 + wc * 32 + 8 * fq;
    f32x4 sc[2][2];
#pragma unroll
    for (int bj = 0; bj < 2; ++bj)
#pragma unroll
      for (int n = 0; n < 2; ++n) sc[bj][n] = scale ? *(const f32x4*)(scale + cb + bj * 128 + n * 4) : (f32x4){1.f, 1.f, 1.f, 1.f};
#pragma unroll
    for (int ai = 0; ai < 2; ++ai)
#pragma unroll
      for (int m = 0; m < 4; ++m) { const int row = rowb + ai * 128 + m * 16;
        const bool pad = row_is_pad(row); float ss = 0.f;
        if (!pad) {
          const bool inb = in.b16 && row_is_main(row);
          const float* ip = hptr(in, row) + cb; float* op = (float*)hptr(outm, row) + cb; const bf16_t* ib = in.b16 + main_off(row) + cb;
#pragma unroll
          for (int bj = 0; bj < 2; ++bj) {
            f32x4 b0, b1;
            if (inb) { const u32x4 w = *(const u32x4*)(ib + bj * 128); b0 = (f32x4){bflo(w.x), bfhi(w.x), bflo(w.y), bfhi(w.y)}; b1 = (f32x4){bflo(w.z), bfhi(w.z), bflo(w.w), bfhi(w.w)}; }
            else { b0 = *(const f32x4*)(ip + bj * 128); b1 = *(const f32x4*)(ip + bj * 128 + 4); }
            const f32x4 o0 = b0 + acc[ai][bj][m][0] * sc[bj][0], o1 = b1 + acc[ai][bj][m][1] * sc[bj][1];
            if (w32) { *(f32x4*)(op + bj * 128) = o0; *(f32x4*)(op + bj * 128 + 4) = o1; }
            if (HB) { ss += ((o0[0] * o0[0] + o0[1] * o0[1]) + (o0[2] * o0[2] + o0[3] * o0[3])) + ((o1[0] * o1[0] + o1[1] * o1[1]) + (o1[2] * o1[2] + o1[3] * o1[3]));
              *(u32x4*)(HB + (size_t)row * 1024 + cb + bj * 128) = pack_v8(o0, o1); } }
        } else if (HB) {
#pragma unroll
          for (int bj = 0; bj < 2; ++bj) *(u32x4*)(HB + (size_t)row * 1024 + cb + bj * 128) = (u32x4){0u, 0u, 0u, 0u};
        }
        if (HB) { ss += __shfl_xor(ss, 16); ss += __shfl_xor(ss, 32); if (fq == 0) SSQH[(size_t)row * 16 + ((coff >> 8) + u.pn) * 4 + wc] = ss; }
      }
  }
};
struct EpiResB {
  static constexpr bool PERM = true; const bf16_t* HB; HMap outm; float* SSQ;
  DI void operator()(AccRef acc, const Unit& u, int wr, int wc, int fr, int fq) const {
    const int rowb = u.pm * 256 + wr * 64 + fr; const int cb = u.pn * 256 + wc * 32 + 8 * fq;
#pragma unroll
    for (int ai = 0; ai < 2; ++ai)
#pragma unroll
      for (int m = 0; m < 4; ++m) { const int row = rowb + ai * 128 + m * 16;
        if (row_is_pad(row)) { if (SSQ && fq == 0) SSQ[(size_t)row * 16 + u.pn * 4 + wc] = 0.f; continue; }
        float ss = 0.f;
        const bool outb = outm.b16 && row_is_main(row);
        float* op = (float*)hptr(outm, row) + cb; const bf16_t* bp = HB + (size_t)row * 1024 + cb; bf16_t* ob = (bf16_t*)outm.b16 + main_off(row) + cb;
#pragma unroll
        for (int bj = 0; bj < 2; ++bj) { const u32x4 b = *(const u32x4*)(bp + bj * 128);
          const f32x4 b0 = {bflo(b.x), bfhi(b.x), bflo(b.y), bfhi(b.y)}, b1 = {bflo(b.z), bfhi(b.z), bflo(b.w), bfhi(b.w)};
          const f32x4 o0 = b0 + acc[ai][bj][m][0], o1 = b1 + acc[ai][bj][m][1];
          if (outb) *(u32x4*)(ob + bj * 128) = pack_v8(o0, o1);
          else { *(f32x4*)(op + bj * 128) = o0; *(f32x4*)(op + bj * 128 + 4) = o1; if (SSQ) *(u32x4*)(ob + bj * 128) = pack_v8(o0, o1); }
          if (SSQ) ss += ((o0[0] * o0[0] + o0[1] * o0[1]) + (o0[2] * o0[2] + o0[3] * o0[3])) + ((o1[0] * o1[0] + o1[1] * o1[1]) + (o1[2] * o1[2] + o1[3] * o1[3])); }
        if (SSQ) { ss += __shfl_xor(ss, 16); ss += __shfl_xor(ss, 32); if (fq == 0) SSQ[(size_t)row * 16 + u.pn * 4 + wc] = ss; } }
  }
};
struct EpiResAtomic {
  static constexpr bool PERM = true; HMap outm; int rowoff;
  DI void operator()(AccRef acc, const Unit& u, int wr, int wc, int fr, int fq) const {
    const int rowb = rowoff + u.pm * 256 + wr * 64 + fr; const int cb = u.pn * 256 + wc * 32 + 8 * fq;
#pragma unroll
    for (int ai = 0; ai < 2; ++ai)
#pragma unroll
      for (int m = 0; m < 4; ++m) { const int row = rowb + ai * 128 + m * 16;
        if (row_is_pad(row)) continue;
        float* op = (float*)hptr(outm, row) + cb;
#pragma unroll
        for (int bj = 0; bj < 2; ++bj)
#pragma unroll
          for (int n = 0; n < 2; ++n)
#pragma unroll
            for (int j = 0; j < 4; ++j) __hip_atomic_fetch_add(op + bj * 128 + n * 4 + j, acc[ai][bj][m][n][j], __ATOMIC_RELAXED, __HIP_MEMORY_SCOPE_AGENT); }
  }
};


DI void transpose_item(const float* W, int pitch, int N, bf16_t* WT, int dpitch, const float* kscale, LAS float* scr, int item, int lane) {
  const int nblk = N / 32, kb = item / nblk, nb = item % nblk, k0 = 64 * kb, n0 = 32 * nb;
#pragma unroll 8
  for (int i = 0; i < 32; ++i) { const int kk = 2 * i + (lane >> 5); scr[kk * 33 + (lane & 31)] = W[(size_t)(k0 + kk) * pitch + n0 + (lane & 31)]; }
  asm volatile("s_waitcnt lgkmcnt(0)" ::: "memory");
  const int c = lane & 7;
  float ks[8];
#pragma unroll
  for (int i = 0; i < 8; ++i) ks[i] = kscale ? kscale[k0 + 8 * c + i] : 1.0f;
#pragma unroll
  for (int j = 0; j < 4; ++j) { const int n = (lane >> 3) + 8 * j; const LAS float* s = scr + (8 * c) * 33 + n;
    u32x4 o; o.x = pk2(s[0 * 33] * ks[0], s[1 * 33] * ks[1]); o.y = pk2(s[2 * 33] * ks[2], s[3 * 33] * ks[3]); o.z = pk2(s[4 * 33] * ks[4], s[5 * 33] * ks[5]); o.w = pk2(s[6 * 33] * ks[6], s[7 * 33] * ks[7]);
    *(u32x4*)(WT + (size_t)(n0 + n) * dpitch + k0 + 8 * c) = o; }
  asm volatile("s_waitcnt lgkmcnt(0)" ::: "memory");
}
DI void conv_job(const float* W, int pitch, int K, int N, bf16_t* WT, int dpitch, const float* kscale, LAS float* scr, int gw, int NGW, int lane) {
  const int items = (K / 64) * (N / 32);
  for (int it = gw; it < items; it += NGW) transpose_item(W, pitch, N, WT, dpitch, kscale, scr, it, lane);
}
enum { CB_UP = 0, CB_DN = 1, CB_MIX = 2 };
DI int grab_item(unsigned* ctr, int lane) { int v = 0; if (lane == 0) v = (int)__hip_atomic_fetch_add(ctr, 1u, __ATOMIC_RELAXED, __HIP_MEMORY_SCOPE_AGENT); return __builtin_amdgcn_readfirstlane(v); }
DI void conv_bundle(KP P, int layer, int kind, LAS unsigned char* lds, int wg_lo) {
  const int tid = otid(), wave = tid >> 6, lane = tid & 63;
  const int nb = ogrid(), b0 = obid(); const int lo = wg_lo < nb ? wg_lo : 0;
  if (b0 < lo) return;
  const int gw = (b0 - lo) * 8 + wave, NGW = (nb - lo) * 8;
  LAS float* scr = (LAS float*)(lds + wave * 8448);
  unsigned char* ws = opq(P->ws);
  const int e = layer >> 1;
  const int total = kind != CB_MIX ? 2048 : ((layer & 1) ? 128 : 2048 + 384);
  for (int it = gw; it < total; it += NGW) {
    if (kind == CB_UP) transpose_item(P->w_mlp_up + (size_t)layer * DM * DFF, DFF, DFF, (bf16_t*)(ws + OFF_WUP), DM, P->mlp_norm + layer * DM, scr, it, lane);
    else if (kind == CB_DN) transpose_item(P->w_mlp_down + (size_t)layer * DM * DFF, DM, DM, (bf16_t*)(ws + OFF_WDN), DFF, nullptr, scr, it, lane);
    else if (layer & 1) transpose_item(P->pool_w + (size_t)(e * 4 + (it >> 5)) * 65536, 256, 256, (bf16_t*)(ws + OFF_WPOOL) + (size_t)(it >> 5) * 65536, 256, nullptr, scr, it & 31, lane);
    else if (it < 1312) transpose_item(P->w_in + (size_t)e * DM * INC, INC, INC, (bf16_t*)(ws + OFF_WIN), DM, layer == 2 ? P->mix_norm + layer * DM : nullptr, scr, it, lane);
    else if (it < 1408) transpose_item(P->w_q_up + (size_t)e * 256 * 768, 768, 768, (bf16_t*)(ws + OFF_WQ), 256, P->qa_norm + e * 256, scr, it - 1312, lane);
    else if (it < 1472) { const int j = it - 1408, h = j >> 4; transpose_item(P->w_kv_up + (size_t)e * 256 * 1024 + h * 256, 1024, 128, (bf16_t*)(ws + OFF_WKN) + (size_t)h * 128 * 256, 256, P->kva_norm + e * 256, scr, j & 15, lane); }
    else if (it < 1536) { const int j = it - 1472, h = j >> 4; transpose_item(P->w_kv_up + (size_t)e * 256 * 1024 + h * 256 + 128, 1024, 128, (bf16_t*)(ws + OFF_WV) + (size_t)h * 128 * 256, 256, P->kva_norm + e * 256, scr, j & 15, lane); }
    else if (it < 2048) transpose_item(P->w_out + (size_t)e * DM * DM, DM, DM, (bf16_t*)(ws + OFF_WOUT), DM, nullptr, scr, it - 1536, lane);
    else { const unsigned z0 = ouz(); *(u32x4*)(ws + OFF_WIN + (size_t)INC * DM * 2 + (size_t)(it - 2048) * 1024 + lane * 16) = (u32x4){z0, z0, z0, z0}; }
  }
}
DI void phase_tables(KP P) {
  const int gt = obid() * 512 + otid(), NT = ogrid() * 512;
  float* cosT = (float*)(opq(P->ws) + OFF_COS); float* sinT = (float*)(opq(P->ws) + OFF_SIN);
  for (int idx = gt; idx < LSEQ * 32; idx += NT) { const int p = idx >> 5, i = idx & 31;
    double rev = (double)p * INVF[i] * 0.15915494309189535; rev -= rint(rev); const float fr = (float)rev;
    cosT[idx] = __builtin_amdgcn_cosf(fr); sinT[idx] = __builtin_amdgcn_sinf(fr); }
  float* lb = (float*)(opq(P->ws) + OFF_LB);
  for (int idx = gt; idx < 512; idx += NT) { const float x0 = P->hgrn_lb[idx], x1 = P->hgrn_lb[512 + idx]; const float d = x0 - x1;
    const float spd = fmaxf(d, 0.f) + log1pf(expf(-fabsf(d))), spn = fmaxf(-d, 0.f) + log1pf(expf(-fabsf(d)));
    lb[idx] = NEG_INF; lb[1024 + idx] = 0.f; lb[512 + idx] = -spd; lb[1536 + idx] = -spn; }
  { const f32x4* xs = (const f32x4*)(P->x + (size_t)32640 * 1024); f32x4* od = (f32x4*)(P->out + (size_t)32640 * 1024);
    for (int idx = gt; idx < 128 * 256; idx += NT) od[idx] = xs[idx]; }
  { u32x4* zb = (u32x4*)P->out; const unsigned z0 = ouz();
    for (int idx = gt; idx < 96 * 128; idx += NT) { const int rr = idx >> 7; const int row = rr < 48 ? rr : LP + rr - 48; zb[(size_t)row * 128 + (idx & 127)] = (u32x4){z0, z0, z0, z0}; } }
  float* hs = (float*)(opq(P->ws) + OFF_HSIDE);
  for (int idx = gt; idx < 2 * 16 * 1024; idx += NT) hs[idx] = P->meta[idx & 16383];
}
DI void phase_norm(const HMap hm, const float* g, bf16_t* U) {
  const int tid = otid(), wave = tid >> 6, lane = tid & 63; const int gw = obid() * 8 + wave, NGW = ogrid() * 8;
  f32x4 gv[4];
#pragma unroll
  for (int j = 0; j < 4; ++j) gv[j] = *(const f32x4*)(g + 4 * lane + 256 * j);
  for (int rb = gw * 2; rb < MT; rb += NGW * 2) {
    f32x4 v[2][4]; bool pad[2];
#pragma unroll
    for (int q = 0; q < 2; ++q) { const int r = rb + q; pad[q] = row_is_pad(r);
      if (!pad[q]) {
        if (hm.b16 && row_is_main(r)) { const u32x2* xb = (const u32x2*)(hm.b16 + main_off(r)) + lane;
#pragma unroll
          for (int j = 0; j < 4; ++j) { const u32x2 w = xb[64 * j]; v[q][j] = (f32x4){bflo(w.x), bfhi(w.x), bflo(w.y), bfhi(w.y)}; } }
        else { const f32x4* xr = (const f32x4*)hptr(hm, r) + lane;
#pragma unroll
          for (int j = 0; j < 4; ++j) v[q][j] = xr[64 * j]; } }
      else {
#pragma unroll
        for (int j = 0; j < 4; ++j) v[q][j] = (f32x4){0.f, 0.f, 0.f, 0.f}; } }
#pragma unroll
    for (int q = 0; q < 2; ++q) { const int r = rb + q; u32x2* o8 = (u32x2*)(U + (size_t)r * 1024) + lane;
      float s = 0.f;
#pragma unroll
      for (int j = 0; j < 4; ++j) s += (v[q][j][0] * v[q][j][0] + v[q][j][1] * v[q][j][1]) + (v[q][j][2] * v[q][j][2] + v[q][j][3] * v[q][j][3]);
      const float rstd = pad[q] ? 0.f : __builtin_amdgcn_rsqf(wave_sum(s) * (1.0f / 1024.0f) + EPS);
#pragma unroll
      for (int j = 0; j < 4; ++j) { const f32x4 y = v[q][j] * rstd * gv[j]; o8[64 * j] = (u32x2){pk2(y[0], y[1]), pk2(y[2], y[3])}; } }
  }
}
DI void acc8(float (&sum)[8], const u32x4 v, float sgn) {
  sum[0] += sgn * bflo(v.x); sum[1] += sgn * bfhi(v.x); sum[2] += sgn * bflo(v.y); sum[3] += sgn * bfhi(v.y);
  sum[4] += sgn * bflo(v.z); sum[5] += sgn * bfhi(v.z); sum[6] += sgn * bflo(v.w); sum[7] += sgn * bfhi(v.w);
}
template <int W>
DI void pool_item(const bf16_t* U, bf16_t* PD, int r0, int col) {
  const unsigned z0 = ouz();
  if (row_is_pad(r0)) {
#pragma unroll
    for (int t = 0; t < 8; ++t) *(u32x4*)(PD + (size_t)(r0 + t) * 1024 + col) = (u32x4){z0, z0, z0, z0};
    return; }
  u32x4 v[8 + W - 1];
#pragma unroll
  for (int i = 0; i < 8 + W - 1; ++i) { const int rr = r0 - (W - 1) + i; v[i] = rr >= 0 ? *(const u32x4*)(U + (size_t)rr * 1024 + col) : (u32x4){z0, z0, z0, z0}; }
  const int pp0 = r0 >= LP ? r0 - LP : r0; const int p0 = pp0 - 48;
  float sum[8] = {0.f, 0.f, 0.f, 0.f, 0.f, 0.f, 0.f, 0.f};
#pragma unroll
  for (int i = 0; i < W - 1; ++i) acc8(sum, v[i], 1.0f);
#pragma unroll
  for (int t = 0; t < 8; ++t) {
    acc8(sum, v[W - 1 + t], 1.0f);
    const int cnt = (p0 + t + 1) < W ? (p0 + t + 1) : W; const float ic = 1.0f / (float)cnt; const u32x4 own = v[W - 1 + t];
    u32x4 o;
    o.x = pk2(sum[0] * ic - bflo(own.x), sum[1] * ic - bfhi(own.x)); o.y = pk2(sum[2] * ic - bflo(own.y), sum[3] * ic - bfhi(own.y));
    o.z = pk2(sum[4] * ic - bflo(own.z), sum[5] * ic - bfhi(own.z)); o.w = pk2(sum[6] * ic - bflo(own.w), sum[7] * ic - bfhi(own.w));
    *(u32x4*)(PD + (size_t)(r0 + t) * 1024 + col) = o;
    acc8(sum, v[t], -1.0f);
  }
}
DI void phase_pooldiff(const bf16_t* U, bf16_t* PD) {
  const int gt = obid() * 512 + otid(), NT = ogrid() * 512;
  for (int idx = gt; idx < (MT / 8) * 128; idx += NT) { const int rb = idx >> 7, ch = idx & 127, col = ch * 8, g = ch >> 5;
    if (g == 0) pool_item<2>(U, PD, rb * 8, col); else if (g == 1) pool_item<4>(U, PD, rb * 8, col); else if (g == 2) pool_item<8>(U, PD, rb * 8, col); else pool_item<16>(U, PD, rb * 8, col); }
}
template <int W>
DI void normpool_item(const LAS unsigned char* ul, bf16_t* PD, int r0, int rg, int col) {
  u32x4 v[8 + W - 1];
#pragma unroll
  for (int i = 0; i < 8 + W - 1; ++i) v[i] = *(const LAS u32x4*)(ul + (15 + rg * 8 - (W - 1) + i) * 2048 + col * 2);
  float sum[8] = {0.f, 0.f, 0.f, 0.f, 0.f, 0.f, 0.f, 0.f};
#pragma unroll
  for (int i = 0; i < W - 1; ++i) acc8(sum, v[i], 1.0f);
#pragma unroll
  for (int t = 0; t < 8; ++t) {
    acc8(sum, v[W - 1 + t], 1.0f);
    const int r = r0 + rg * 8 + t; const bool pad = row_is_pad(r); const int pp = r >= LP ? r - LP : r; const int p = pp - 48;
    const int cnt = (p + 1) < W ? (p + 1) : W; const float ic = pad ? 0.f : 1.0f / (float)cnt; const u32x4 own = v[W - 1 + t];
    u32x4 o;
    o.x = pk2(sum[0] * ic - bflo(own.x), sum[1] * ic - bfhi(own.x)); o.y = pk2(sum[2] * ic - bflo(own.y), sum[3] * ic - bfhi(own.y));
    o.z = pk2(sum[4] * ic - bflo(own.z), sum[5] * ic - bfhi(own.z)); o.w = pk2(sum[6] * ic - bflo(own.w), sum[7] * ic - bfhi(own.w));
    *(u32x4*)(PD + (size_t)r * 1024 + col) = o;
    acc8(sum, v[t], -1.0f);
  }
}
DI void phase_normpool(const HMap hm, const float* g, bf16_t* PD, LAS unsigned char* lds) {
  const int tid = otid(), wave = tid >> 6, lane = tid & 63;
  f32x4 gv[4];
#pragma unroll
  for (int j = 0; j < 4; ++j) gv[j] = *(const f32x4*)(g + 4 * lane + 256 * j);
  for (int blk = obid(); blk < MT / 48; blk += ogrid()) {
    const int r0 = blk * 48;
    for (int lb = wave; lb < 63; lb += 16) {
      f32x4 v[2][4]; bool pad[2];
#pragma unroll
      for (int q = 0; q < 2; ++q) { const int li = lb + 8 * q; const int r = r0 - 15 + li; pad[q] = (li >= 63) || (r < 0) || row_is_pad(r);
        if (!pad[q]) {
          if (hm.b16 && row_is_main(r)) { const u32x2* xb = (const u32x2*)(hm.b16 + main_off(r)) + lane;
#pragma unroll
            for (int j = 0; j < 4; ++j) { const u32x2 w = xb[64 * j]; v[q][j] = (f32x4){bflo(w.x), bfhi(w.x), bflo(w.y), bfhi(w.y)}; } }
          else { const f32x4* xr = (const f32x4*)hptr(hm, r) + lane;
#pragma unroll
            for (int j = 0; j < 4; ++j) v[q][j] = xr[64 * j]; } }
        else {
#pragma unroll
          for (int j = 0; j < 4; ++j) v[q][j] = (f32x4){0.f, 0.f, 0.f, 0.f}; } }
#pragma unroll
      for (int q = 0; q < 2; ++q) { const int li = lb + 8 * q;
        float s_ = 0.f;
#pragma unroll
        for (int j = 0; j < 4; ++j) s_ += (v[q][j][0] * v[q][j][0] + v[q][j][1] * v[q][j][1]) + (v[q][j][2] * v[q][j][2] + v[q][j][3] * v[q][j][3]);
        const float rstd = pad[q] ? 0.f : __builtin_amdgcn_rsqf(wave_sum(s_) * (1.0f / 1024.0f) + EPS);
        if (li < 63) { LAS u32x2* o8 = (LAS u32x2*)(lds + li * 2048) + lane;
#pragma unroll
          for (int j = 0; j < 4; ++j) { const f32x4 y = v[q][j] * rstd * gv[j]; o8[64 * j] = (u32x2){pk2(y[0], y[1]), pk2(y[2], y[3])}; } } }
    }
    __syncthreads();
    for (int item = tid; item < 768; item += 512) { const int rg = item >> 7, ch = item & 127, col = ch * 8, gq = ch >> 5;
      if (gq == 0) normpool_item<2>(lds, PD, r0, rg, col); else if (gq == 1) normpool_item<4>(lds, PD, r0, rg, col); else if (gq == 2) normpool_item<8>(lds, PD, r0, rg, col); else normpool_item<16>(lds, PD, r0, rg, col); }
    __syncthreads();
  }
}
DI void phase_qkfinal(KP P, int e, int wg, int nwg) {
  const int tid = otid(), wave = tid >> 6, lane = tid & 63; const int gw = wg * 8 + wave, NGW = nwg * 8;
  const int hd = lane >> 4, li = lane & 15;
  bf16_t* QP = (bf16_t*)(opq(P->ws) + OFF_BIG + B_QP); bf16_t* KK = (bf16_t*)(opq(P->ws) + OFF_BIG + B_KK); const bf16_t* KR = (const bf16_t*)(opq(P->ws) + OFF_BIG + B_KR);
  const float* cosT = (const float*)(opq(P->ws) + OFF_COS); const float* sinT = (const float*)(opq(P->ws) + OFF_SIN);
  const float* qg = P->q_norm + e * 192; const float* kg = P->k_norm + e * 192;
  float qgn[8], kgn[8];
#pragma unroll
  for (int j = 0; j < 8; ++j) { qgn[j] = qg[8 * li + j]; kgn[j] = kg[8 * li + j]; }
  const float qg1a = qg[128 + 2 * li], qg1b = qg[129 + 2 * li], qg2a = qg[160 + 2 * li], qg2b = qg[161 + 2 * li];
  const float kg1a = kg[128 + 2 * li], kg1b = kg[129 + 2 * li], kg2a = kg[160 + 2 * li], kg2b = kg[161 + 2 * li];
  const float SCQ = 0.07216878364870322f * 1.44269504088896f;
  for (int rb = gw * 2; rb < MR; rb += NGW * 2) {
    f32x2 cs[2], sn[2]; u32x4 qn[2], kn[2]; unsigned q1[2], q2[2], k1[2], k2[2];
#pragma unroll
    for (int q = 0; q < 2; ++q) { const int r = rb + q; const int pp = r >= LP ? r - LP : r; const int p = pp >= 48 ? pp - 48 : 0;
      cs[q] = *(const f32x2*)(cosT + p * 32 + 2 * li); sn[q] = *(const f32x2*)(sinT + p * 32 + 2 * li);
      const bf16_t* qp = QP + (size_t)r * 768 + hd * 192; const bf16_t* kp = KK + (size_t)r * 768 + hd * 192;
      qn[q] = *(const u32x4*)(qp + 8 * li); q1[q] = *(const unsigned*)(qp + 128 + 2 * li); q2[q] = *(const unsigned*)(qp + 160 + 2 * li);
      kn[q] = *(const u32x4*)(kp + 8 * li); k1[q] = *(const unsigned*)(KR + (size_t)r * 64 + 2 * li); k2[q] = *(const unsigned*)(KR + (size_t)r * 64 + 32 + 2 * li); }
#pragma unroll
    for (int q = 0; q < 2; ++q) { const int r = rb + q;
      { bf16_t* qp = QP + (size_t)r * 768 + hd * 192;
        float x[8] = {bflo(qn[q].x), bfhi(qn[q].x), bflo(qn[q].y), bfhi(qn[q].y), bflo(qn[q].z), bfhi(qn[q].z), bflo(qn[q].w), bfhi(qn[q].w)};
        const float x1a = bflo(q1[q]), x1b = bfhi(q1[q]), x2a = bflo(q2[q]), x2b = bfhi(q2[q]);
        float s_ = (x1a * x1a + x1b * x1b) + (x2a * x2a + x2b * x2b);
#pragma unroll
        for (int j = 0; j < 8; ++j) s_ += x[j] * x[j];
        s_ += __shfl_xor(s_, 1); s_ += __shfl_xor(s_, 2); s_ += __shfl_xor(s_, 4); s_ += __shfl_xor(s_, 8);
        const float rs = __builtin_amdgcn_rsqf(s_ * (1.0f / 192.0f) + EPS) * SCQ;
        u32x4 o; o.x = pk2(x[0] * qgn[0] * rs, x[1] * qgn[1] * rs); o.y = pk2(x[2] * qgn[2] * rs, x[3] * qgn[3] * rs); o.z = pk2(x[4] * qgn[4] * rs, x[5] * qgn[5] * rs); o.w = pk2(x[6] * qgn[6] * rs, x[7] * qgn[7] * rs);
        const float a0 = x1a * qg1a * rs, a1 = x1b * qg1b * rs, b0 = x2a * qg2a * rs, b1 = x2b * qg2b * rs;
        *(u32x4*)(qp + 8 * li) = o;
        *(unsigned*)(qp + 128 + 2 * li) = pk2(a0 * cs[q][0] - b0 * sn[q][0], a1 * cs[q][1] - b1 * sn[q][1]);
        *(unsigned*)(qp + 160 + 2 * li) = pk2(b0 * cs[q][0] + a0 * sn[q][0], b1 * cs[q][1] + a1 * sn[q][1]); }
      { bf16_t* kp = KK + (size_t)r * 768 + hd * 192;
        float x[8] = {bflo(kn[q].x), bfhi(kn[q].x), bflo(kn[q].y), bfhi(kn[q].y), bflo(kn[q].z), bfhi(kn[q].z), bflo(kn[q].w), bfhi(kn[q].w)};
        const float x1a = bflo(k1[q]), x1b = bfhi(k1[q]), x2a = bflo(k2[q]), x2b = bfhi(k2[q]);
        float s_ = (x1a * x1a + x1b * x1b) + (x2a * x2a + x2b * x2b);
#pragma unroll
        for (int j = 0; j < 8; ++j) s_ += x[j] * x[j];
        s_ += __shfl_xor(s_, 1); s_ += __shfl_xor(s_, 2); s_ += __shfl_xor(s_, 4); s_ += __shfl_xor(s_, 8);
        const float rs = __builtin_amdgcn_rsqf(s_ * (1.0f / 192.0f) + EPS);
        u32x4 o; o.x = pk2(x[0] * kgn[0] * rs, x[1] * kgn[1] * rs); o.y = pk2(x[2] * kgn[2] * rs, x[3] * kgn[3] * rs); o.z = pk2(x[4] * kgn[4] * rs, x[5] * kgn[5] * rs); o.w = pk2(x[6] * kgn[6] * rs, x[7] * kgn[7] * rs);
        const float a0 = x1a * kg1a * rs, a1 = x1b * kg1b * rs, b0 = x2a * kg2a * rs, b1 = x2b * kg2b * rs;
        *(u32x4*)(kp + 8 * li) = o;
        *(unsigned*)(kp + 128 + 2 * li) = pk2(a0 * cs[q][0] - b0 * sn[q][0], a1 * cs[q][1] - b1 * sn[q][1]);
        *(unsigned*)(kp + 160 + 2 * li) = pk2(b0 * cs[q][0] + a0 * sn[q][0], b1 * cs[q][1] + a1 * sn[q][1]); } }
  }
}

constexpr int HROW = 144;
constexpr int QROW = 272;
DI float clampe(float x) { return fminf(fmaxf(x, -80.f), 80.f); }
template <int OFF>
DI void h1_produce(const float (&b)[64], float blast, const bf16_t* vcol, LAS unsigned char* kd_row, LAS unsigned char* vt_row) {
  unsigned kw[16], vw[16];
#pragma unroll
  for (int i = 0; i < 32; i += 2) {
    const int s0 = OFF + i, s1 = OFF + i + 1;
    const float lf0 = s0 == 0 ? b[0] : b[s0] - b[s0 - 1], lf1 = b[s1] - b[s1 - 1];
    const float k0 = (1.0f - fexp(lf0)) * fexp(blast - b[s0]), k1 = (1.0f - fexp(lf1)) * fexp(blast - b[s1]);
    kw[i >> 1] = pk2(k0, k1);
    vw[i >> 1] = (unsigned)vcol[(size_t)s0 * 512] | ((unsigned)vcol[(size_t)s1 * 512] << 16);
  }
#pragma unroll
  for (int q = 0; q < 4; ++q) {
    *(LAS u32x4*)(kd_row + OFF * 2 + 16 * q) = (u32x4){kw[4 * q], kw[4 * q + 1], kw[4 * q + 2], kw[4 * q + 3]};
    *(LAS u32x4*)(vt_row + OFF * 2 + 16 * q) = (u32x4){vw[4 * q], vw[4 * q + 1], vw[4 * q + 2], vw[4 * q + 3]};
  }
}
DI void h1_unit(KP P, LAS unsigned char* lds, int gc, int hp) {
  const int tid = otid(), wave = tid >> 6, lane = tid & 63, r31 = lane & 31, hh = lane >> 5;
  const int thalf = tid >> 8, hd2 = (tid >> 7) & 1, k = tid & 127; const int head = 2 * hp + hd2, col = head * 128 + k;
  const _Float16* LOGF = (const _Float16*)(opq(P->ws) + OFF_BIG + B_LOGF); const bf16_t* VH = (const bf16_t*)(opq(P->ws) + OFF_BIG + B_VH);
  float* DEC = (float*)(opq(P->ws) + OFF_DEC); bf16_t* ST = (bf16_t*)(opq(P->ws) + OFF_BIG + B_ST);
  const size_t r0 = (size_t)gc * 64;
  LAS unsigned char* KD = lds; LAS unsigned char* VTL = lds + 2 * 128 * HROW;
  float b[64];
#pragma unroll
  for (int s = 0; s < 64; ++s) b[s] = (float)LOGF[(r0 + s) * 512 + col];
#pragma unroll
  for (int s = 1; s < 64; ++s) b[s] += b[s - 1];
  const float blast = b[63];
  if (thalf == 0) { DEC[(size_t)gc * 512 + col] = fexp(blast);
    h1_produce<0>(b, blast, VH + r0 * 512 + col, KD + (hd2 * 128 + k) * HROW, VTL + (hd2 * 128 + k) * HROW); }
  else h1_produce<32>(b, blast, VH + r0 * 512 + col, KD + (hd2 * 128 + k) * HROW, VTL + (hd2 * 128 + k) * HROW);
  __syncthreads();
  { const int whd = wave >> 2, kt = wave & 3;
    f32x16 acc[4];
#pragma unroll
    for (int vt = 0; vt < 4; ++vt)
#pragma unroll
      for (int i = 0; i < 16; ++i) acc[vt][i] = 0.f;
    const LAS unsigned char* ka = KD + (whd * 128 + kt * 32 + r31) * HROW + 16 * hh;
    const LAS unsigned char* vb = VTL + (whd * 128 + r31) * HROW + 16 * hh;
#pragma unroll
    for (int ks = 0; ks < 4; ++ks) { const bf16x8 a = *(const LAS bf16x8*)(ka + 32 * ks);
#pragma unroll
      for (int vt = 0; vt < 4; ++vt) { const bf16x8 bb = *(const LAS bf16x8*)(vb + vt * 32 * HROW + 32 * ks); acc[vt] = MFMA32(a, bb, acc[vt]); } }
    bf16_t* sp = ST + ((size_t)(gc * 4 + 2 * hp + whd) * 128) * 128 + kt * 32 + 4 * hh;
#pragma unroll
    for (int vt = 0; vt < 4; ++vt)
#pragma unroll
      for (int rq = 0; rq < 4; ++rq)
        *(u32x2*)(sp + (size_t)(vt * 32 + r31) * 128 + 8 * rq) = (u32x2){pk2(acc[vt][4 * rq], acc[vt][4 * rq + 1]), pk2(acc[vt][4 * rq + 2], acc[vt][4 * rq + 3])};
  }
  __syncthreads();
}
DI void phase_h2(KP P, int wg, int nwg) {
  u32x2* STw = (u32x2*)(opq(P->ws) + OFF_BIG + B_ST); const float* DEC = (const float*)(opq(P->ws) + OFF_DEC);
  for (int g = wg; g < 64; g += nwg) {
    const int gid = g * 512 + otid(); const int b = gid >> 14, rem = gid & 16383, hd = rem >> 12, kq = rem & 31;
    u32x2* sp = STw + (size_t)b * NCH * 16384 + rem;
    const f32x4* dp = (const f32x4*)(DEC + (size_t)b * NCH * 512 + hd * 128 + 4 * kq);
    float s0 = 0.f, s1 = 0.f, s2 = 0.f, s3 = 0.f;
    for (int c0 = 0; c0 < NCH; c0 += 24) {
      u32x2 uu[24]; f32x4 dd[24];
#pragma unroll
      for (int i = 0; i < 24; ++i) if (c0 + i < NCH) { uu[i] = sp[(size_t)(c0 + i) * 16384]; dd[i] = dp[(size_t)(c0 + i) * 128]; }
#pragma unroll
      for (int i = 0; i < 24; ++i) if (c0 + i < NCH) { sp[(size_t)(c0 + i) * 16384] = (u32x2){pk2(s0, s1), pk2(s2, s3)};
        s0 = dd[i][0] * s0 + bflo(uu[i].x); s1 = dd[i][1] * s1 + bfhi(uu[i].x); s2 = dd[i][2] * s2 + bflo(uu[i].y); s3 = dd[i][3] * s3 + bfhi(uu[i].y); }
    }
  }
}
template <int OFF>
DI void h3_produce(const float (&b)[64], float bref, const bf16_t* qcol, const bf16_t* vcol, LAS unsigned char* qm_col, LAS unsigned char* km_col, LAS unsigned char* vt_row) {
  unsigned vw[16];
#pragma unroll
  for (int i = 0; i < 32; ++i) { const int s = OFF + i;
    const float lf = s == 0 ? b[0] : b[s] - b[s - 1];
    const float q = bf2f(qcol[(size_t)s * 512]);
    const float qm = q * fexp(clampe(b[s] - bref)); const float km = (1.0f - fexp(lf)) * fexp(clampe(bref - b[s]));
    *(LAS bf16_t*)(qm_col + s * QROW) = (bf16_t)(pk2(qm, 0.f) & 0xffffu);
    *(LAS bf16_t*)(km_col + s * QROW) = (bf16_t)(pk2(km, 0.f) & 0xffffu);
    const unsigned v = vcol[(size_t)s * 512];
    if (i & 1) vw[i >> 1] |= v << 16; else vw[i >> 1] = v; }
#pragma unroll
  for (int q = 0; q < 4; ++q) *(LAS u32x4*)(vt_row + OFF * 2 + 16 * q) = (u32x4){vw[4 * q], vw[4 * q + 1], vw[4 * q + 2], vw[4 * q + 3]};
}
DI void h3_unit(KP P, int e, LAS unsigned char* lds, int gc, int hp) {
  const int tid = otid(), wave = tid >> 6, lane = tid & 63, r31 = lane & 31, hh = lane >> 5;
  const _Float16* LOGF = (const _Float16*)(opq(P->ws) + OFF_BIG + B_LOGF); const bf16_t* VH = (const bf16_t*)(opq(P->ws) + OFF_BIG + B_VH);
  const bf16_t* QH = (const bf16_t*)(opq(P->ws) + OFF_BIG + B_QH); const bf16_t* GT = (const bf16_t*)(opq(P->ws) + OFF_BIG + B_GT);
  const bf16_t* ST = (const bf16_t*)(opq(P->ws) + OFF_BIG + B_ST); bf16_t* MIX = (bf16_t*)(opq(P->ws) + OFF_U);
  const size_t r0 = (size_t)gc * 64;
  LAS unsigned char* QM = lds; LAS unsigned char* KM = lds + 2 * 64 * QROW; LAS unsigned char* VTL = lds + 4 * 64 * QROW;
  LAS float* EREF = (LAS float*)(lds + 4 * 64 * QROW + 2 * 128 * HROW); LAS float* RED = EREF + 256;
  { const int thalf = tid >> 8, hd2 = (tid >> 7) & 1, k = tid & 127; const int head = 2 * hp + hd2, col = head * 128 + k;
    float b[64];
#pragma unroll
    for (int s = 0; s < 64; ++s) b[s] = (float)LOGF[(r0 + s) * 512 + col];
#pragma unroll
    for (int s = 1; s < 64; ++s) b[s] += b[s - 1];
    const float bref = b[31];
    LAS unsigned char* qc = QM + hd2 * 64 * QROW + k * 2; LAS unsigned char* kc = KM + hd2 * 64 * QROW + k * 2; LAS unsigned char* vr = VTL + (hd2 * 128 + k) * HROW;
    if (thalf == 0) { EREF[hd2 * 128 + k] = fexp(bref); h3_produce<0>(b, bref, QH + r0 * 512 + col, VH + r0 * 512 + col, qc, kc, vr); }
    else h3_produce<32>(b, bref, QH + r0 * 512 + col, VH + r0 * 512 + col, qc, kc, vr);
  }
  const int hd2 = wave >> 2, tq = (wave >> 1) & 1, vh = wave & 1; const int head = 2 * hp + hd2;
  u32x4 sraw[2][8]; u32x2 gtv[2][4];
  { const bf16_t* sg0 = ST + ((size_t)(gc * 4 + head) * 128 + vh * 64 + r31) * 128 + 8 * hh;
#pragma unroll
    for (int vt = 0; vt < 2; ++vt)
#pragma unroll
      for (int ks = 0; ks < 8; ++ks) sraw[vt][ks] = *(const u32x4*)(sg0 + (size_t)vt * 32 * 128 + 16 * ks);
    const size_t row0 = r0 + 32 * tq + r31;
#pragma unroll
    for (int vt = 0; vt < 2; ++vt)
#pragma unroll
      for (int rq = 0; rq < 4; ++rq) gtv[vt][rq] = *(const u32x2*)(GT + row0 * 512 + head * 128 + vh * 64 + vt * 32 + 8 * rq + 4 * hh); }
  __syncthreads();
  f32x16 acc[2];
#pragma unroll
  for (int i = 0; i < 16; ++i) { acc[0][i] = 0.f; acc[1][i] = 0.f; }
  const LAS unsigned char* qb = QM + (hd2 * 64 + 32 * tq + r31) * QROW + 16 * hh;
  const LAS unsigned char* vb = VTL + (hd2 * 128 + vh * 64 + r31) * HROW + 16 * hh;
#pragma unroll
  for (int st = 0; st < 2; ++st) {
    if (st <= tq) {
      f32x16 att;
#pragma unroll
      for (int i = 0; i < 16; ++i) att[i] = 0.f;
      const LAS unsigned char* kb = KM + (hd2 * 64 + 32 * st + perm32k(r31)) * QROW + 16 * hh;
#pragma unroll
      for (int ks = 0; ks < 8; ++ks) { const bf16x8 a = *(const LAS bf16x8*)(kb + 32 * ks); const bf16x8 bq = *(const LAS bf16x8*)(qb + 32 * ks); att = MFMA32(a, bq, att); }
      if (st == tq) {
#pragma unroll
        for (int reg = 0; reg < 16; ++reg) { const int sl = (reg & 3) + 8 * hh + 4 * ((reg >> 2) & 1) + 16 * (reg >> 3); if (sl > r31) att[reg] = 0.f; } }
#pragma unroll
      for (int s2 = 0; s2 < 2; ++s2) { const bf16x8 pf = pack8(att, s2);
#pragma unroll
        for (int vt = 0; vt < 2; ++vt) { const bf16x8 a = *(const LAS bf16x8*)(vb + vt * 32 * HROW + (32 * st + 16 * s2) * 2); acc[vt] = MFMA32(a, pf, acc[vt]); } }
    }
  }
  { const LAS float* er = EREF + hd2 * 128 + 8 * hh;
#pragma unroll
    for (int ks = 0; ks < 8; ++ks) { const bf16x8 bq = *(const LAS bf16x8*)(qb + 32 * ks);
      const f32x4 e0 = *(const LAS f32x4*)(er + 16 * ks), e1 = *(const LAS f32x4*)(er + 16 * ks + 4);
#pragma unroll
      for (int vt = 0; vt < 2; ++vt) { const u32x4 raw = sraw[vt][ks];
        u32x4 w; w.x = pk2(bflo(raw.x) * e0[0], bfhi(raw.x) * e0[1]); w.y = pk2(bflo(raw.y) * e0[2], bfhi(raw.y) * e0[3]); w.z = pk2(bflo(raw.z) * e1[0], bfhi(raw.z) * e1[1]); w.w = pk2(bflo(raw.w) * e1[2], bfhi(raw.w) * e1[3]);
        acc[vt] = MFMA32(__builtin_bit_cast(bf16x8, w), bq, acc[vt]); } } }
  float ss = 0.f;
#pragma unroll
  for (int i = 0; i < 16; ++i) ss += acc[0][i] * acc[0][i] + acc[1][i] * acc[1][i];
  ss += __shfl_xor(ss, 32);
  if (hh == 0) RED[((hd2 * 2 + tq) * 2 + vh) * 32 + r31] = ss;
  __syncthreads();
  const float tot = RED[((hd2 * 2 + tq) * 2 + 0) * 32 + r31] + RED[((hd2 * 2 + tq) * 2 + 1) * 32 + r31];
  const float rstd = __builtin_amdgcn_rsqf(tot * (1.0f / 128.0f) + EPS);
  const size_t row = r0 + 32 * tq + r31; const float* og = P->hgrn_out_norm + e * 128;
#pragma unroll
  for (int vt = 0; vt < 2; ++vt)
#pragma unroll
    for (int rq = 0; rq < 4; ++rq) { const int v = vh * 64 + vt * 32 + 8 * rq + 4 * hh;
      const u32x2 gt = gtv[vt][rq]; const f32x4 gn = *(const f32x4*)(og + v);
      const float o0 = acc[vt][4 * rq] * rstd * gn[0] * bflo(gt.x), o1 = acc[vt][4 * rq + 1] * rstd * gn[1] * bfhi(gt.x), o2 = acc[vt][4 * rq + 2] * rstd * gn[2] * bflo(gt.y), o3 = acc[vt][4 * rq + 3] * rstd * gn[3] * bfhi(gt.y);
      *(u32x2*)(MIX + row * 1024 + head * 128 + v) = (u32x2){pk2(o0, o1), pk2(o2, o3)}; }
}

constexpr int KROWB = 400, ATT_KB = 64 * KROWB, ATT_VB = 128 * HROW;
DI void attn_unit(LAS unsigned char* lds, const bf16_t* __restrict__ Q, const bf16_t* __restrict__ Kg, const bf16_t* __restrict__ VT, bf16_t* __restrict__ MIX, int b, int h, int c0, int nq, int desc) {
  const int tid = otid(), wave = tid >> 6, lane = tid & 63, r31 = lane & 31, hh = lane >> 5;
  const bool active = (wave >> 1) < nq; const int cq = c0 + (wave >> 1); const int nt = c0 + nq;
  const size_t qrow = (size_t)b * LP + 64 * c0 + (active ? 32 * wave + r31 : 0);
  bf16x8 qf[12];
  { const bf16_t* qp = Q + qrow * 768 + h * 192 + 8 * hh;
#pragma unroll
    for (int s = 0; s < 12; ++s) qf[s] = *(const bf16x8*)(qp + 16 * s); }
  f32x16 O[4];
#pragma unroll
  for (int d = 0; d < 4; ++d)
#pragma unroll
    for (int i = 0; i < 16; ++i) O[d][i] = 0.f;
  float mrun = NEG_INF, lrun = 0.f;
  const bf16_t* kbase = Kg + (size_t)b * LP * 768 + h * 192;
  const bf16_t* vbase = VT + (size_t)(b * 4 + h) * 128 * LP;
  u32x4 kreg[3], vreg[2];
#define ATT_LOAD(t) do { _Pragma("unroll") for (int i = 0; i < 3; ++i) { const int ci = tid + 512 * i; const int rr = ci / 24, ch = ci % 24; kreg[i] = *(const u32x4*)(kbase + (size_t)(64 * (t) + rr) * 768 + ch * 8); } \
    _Pragma("unroll") for (int i = 0; i < 2; ++i) { const int ci = tid + 512 * i; const int dd = ci >> 3, ch = ci & 7; vreg[i] = *(const u32x4*)(vbase + (size_t)dd * LP + 64 * (t) + ch * 8); } } while (0)
#define ATT_STORE(buf) do { _Pragma("unroll") for (int i = 0; i < 3; ++i) { const int ci = tid + 512 * i; const int rr = ci / 24, ch = ci % 24; *(LAS u32x4*)(lds + (buf) * ATT_KB + rr * KROWB + ch * 16) = kreg[i]; } \
    _Pragma("unroll") for (int i = 0; i < 2; ++i) { const int ci = tid + 512 * i; const int dd = ci >> 3, ch = ci & 7; *(LAS u32x4*)(lds + 2 * ATT_KB + (buf) * ATT_VB + dd * HROW + ch * 16) = vreg[i]; } } while (0)
  const unsigned kgo = (unsigned)((tid >> 3) * 768 + (tid & 7) * 8), klo = (unsigned)((tid >> 3) * KROWB + (tid & 7) * 16);
  const unsigned vgo = (unsigned)((tid >> 2) * LP + (tid & 3) * 8), vlo = (unsigned)(2 * ATT_KB + (tid >> 2) * HROW + (tid & 3) * 16);
#define ATT_LOADK(t) do { const bf16_t* kp_ = kbase + (size_t)(64 * (t)) * 768 + kgo; _Pragma("unroll") for (int i = 0; i < 3; ++i) kreg[i] = *(const u32x4*)(kp_ + 64 * i); } while (0)
#define ATT_LOADV(t) do { const bf16_t* vp_ = vbase + 64 * (t) + vgo; _Pragma("unroll") for (int i = 0; i < 2; ++i) vreg[i] = *(const u32x4*)(vp_ + 32 * i); } while (0)
#define ATT_STOREK(buf) do { _Pragma("unroll") for (int i = 0; i < 3; ++i) *(LAS u32x4*)(lds + (buf) * ATT_KB + klo + 128 * i) = kreg[i]; } while (0)
#define ATT_STOREV(buf) do { _Pragma("unroll") for (int i = 0; i < 2; ++i) *(LAS u32x4*)(lds + (buf) * ATT_VB + vlo + 64 * i) = vreg[i]; } while (0)
#define ATT_QK(buf, S0, S1) do { _Pragma("unroll") for (int i = 0; i < 16; ++i) { S0[i] = 0.f; S1[i] = 0.f; } \
    const LAS unsigned char* kb_ = lds + (buf) * ATT_KB + perm32k(r31) * KROWB + 16 * hh; \
    _Pragma("unroll") for (int s = 0; s < 12; ++s) { const bf16x8 a0 = *(const LAS bf16x8*)(kb_ + 32 * s); const bf16x8 a1 = *(const LAS bf16x8*)(kb_ + 32 * KROWB + 32 * s); \
      S0 = MFMA32(a0, qf[s], S0); S1 = MFMA32(a1, qf[s], S1); } } while (0)
  f32x16 s0, s1, n0, n1;
#define TAU(t) (desc ? nt - 1 - (t) : (t))
  ATT_LOADK(TAU(0)); ATT_LOADV(TAU(0)); ATT_STOREK(0); ATT_STOREV(0);
  if (nt > 1) { ATT_LOADK(TAU(1)); ATT_STOREK(1); }
  __syncthreads();
  if (active) ATT_QK(0, s0, s1);
  __syncthreads();
  for (int t = 0; t < nt; ++t) {
    const int buf = t & 1; const int tau = TAU(t), taun = TAU(t + 1);
    if (t + 2 < nt) ATT_LOADK(TAU(t + 2));
    if (t + 1 < nt) ATT_LOADV(taun);
    const bool do_cur = active && tau <= cq; const bool do_next = active && (taun <= cq) && (t + 1 < nt);
    if (do_cur && do_next && tau != 0) {
      float mx = fmaxf(s0[0], s1[0]);
#pragma unroll
      for (int i = 1; i < 16; ++i) mx = fmaxf(mx, fmaxf(s0[i], s1[i]));
      mx = fmaxf(mx, __shfl_xor(mx, 32));
      const float mn = fmaxf(mrun, mx);
      if (__builtin_amdgcn_ballot_w64(mn > mrun) != 0ull) {
        const float alpha = __builtin_amdgcn_exp2f(mrun - mn); mrun = mn; lrun *= alpha;
#pragma unroll
        for (int d = 0; d < 4; ++d) O[d] = O[d] * alpha; }
#pragma unroll
      for (int i = 0; i < 16; ++i) { n0[i] = 0.f; n1[i] = 0.f; }
      const LAS unsigned char* kb2 = lds + (buf ^ 1) * ATT_KB + perm32k(r31) * KROWB + 16 * hh;
      __builtin_amdgcn_sched_barrier(0);
#pragma unroll
      for (int sx = 0; sx < 12; ++sx) { const bf16x8 a0 = *(const LAS bf16x8*)(kb2 + 32 * sx); const bf16x8 a1 = *(const LAS bf16x8*)(kb2 + 32 * KROWB + 32 * sx);
        n0 = MFMA32(a0, qf[sx], n0); n1 = MFMA32(a1, qf[sx], n1);
#pragma unroll
        for (int j = 0; j < 3; ++j) { const int ei = 3 * sx + j; if (ei < 16) s0[ei] = __builtin_amdgcn_exp2f(s0[ei] - mrun); else if (ei < 32) s1[ei - 16] = __builtin_amdgcn_exp2f(s1[ei - 16] - mrun); }
        __builtin_amdgcn_sched_barrier(0); }
      float ps = 0.f;
#pragma unroll
      for (int i = 0; i < 16; ++i) ps += s0[i] + s1[i];
      lrun += ps;
      bf16x8 pf[4]; pf[0] = pack8(s0, 0); pf[1] = pack8(s0, 1); pf[2] = pack8(s1, 0); pf[3] = pack8(s1, 1);
      const LAS unsigned char* vb = lds + 2 * ATT_KB + buf * ATT_VB + r31 * HROW + 16 * hh;
#pragma unroll
      for (int kk = 0; kk < 4; ++kk)
#pragma unroll
        for (int d = 0; d < 4; ++d) { const bf16x8 a = *(const LAS bf16x8*)(vb + d * 32 * HROW + 32 * kk); O[d] = MFMA32(a, pf[kk], O[d]); }
    } else {
    if (do_next) ATT_QK(buf ^ 1, n0, n1);
    if (do_cur) {
      if (tau == 0) {
#pragma unroll
        for (int i = 0; i < 16; ++i) s0[i] = NEG_INF;
#pragma unroll
        for (int i = 0; i < 8; ++i) s1[i] = NEG_INF; }
      float mx = fmaxf(s0[0], s1[0]);
#pragma unroll
      for (int i = 1; i < 16; ++i) mx = fmaxf(mx, fmaxf(s0[i], s1[i]));
      mx = fmaxf(mx, __shfl_xor(mx, 32));
      const float mn = fmaxf(mrun, mx);
      if (__builtin_amdgcn_ballot_w64(mn > mrun) != 0ull) {
        const float alpha = __builtin_amdgcn_exp2f(mrun - mn); mrun = mn; lrun *= alpha;
#pragma unroll
        for (int d = 0; d < 4; ++d) O[d] = O[d] * alpha; }
      float ps = 0.f;
#pragma unroll
      for (int i = 0; i < 16; ++i) { s0[i] = __builtin_amdgcn_exp2f(s0[i] - mrun); s1[i] = __builtin_amdgcn_exp2f(s1[i] - mrun); ps += s0[i] + s1[i]; }
      lrun += ps;
      bf16x8 pf[4]; pf[0] = pack8(s0, 0); pf[1] = pack8(s0, 1); pf[2] = pack8(s1, 0); pf[3] = pack8(s1, 1);
      const LAS unsigned char* vb = lds + 2 * ATT_KB + buf * ATT_VB + r31 * HROW + 16 * hh;
#pragma unroll
      for (int kk = 0; kk < 4; ++kk)
#pragma unroll
        for (int d = 0; d < 4; ++d) { const bf16x8 a = *(const LAS bf16x8*)(vb + d * 32 * HROW + 32 * kk); O[d] = MFMA32(a, pf[kk], O[d]); }
    }
    }
    if (t + 2 < nt) ATT_STOREK(buf);
    if (t + 1 < nt) ATT_STOREV(buf ^ 1);
    __syncthreads();
    s0 = n0; s1 = n1;
  }
#undef ATT_LOADK
#undef ATT_LOADV
#undef ATT_STOREK
#undef ATT_STOREV
#undef ATT_QK
#undef TAU
#undef ATT_LOAD
#undef ATT_STORE
  if (active) {
    const float lt = lrun + __shfl_xor(lrun, 32); const float inv = 1.0f / lt;
    bf16_t* op = MIX + qrow * 1024 + 512 + h * 128 + 4 * hh;
#pragma unroll
    for (int d = 0; d < 4; ++d)
#pragma unroll
      for (int rq = 0; rq < 4; ++rq)
        *(u32x2*)(op + d * 32 + 8 * rq) = (u32x2){pk2(O[d][4 * rq] * inv, O[d][4 * rq + 1] * inv), pk2(O[d][4 * rq + 2] * inv, O[d][4 * rq + 3] * inv)};
  }
}
DI void phase_attn(KP P, LAS unsigned char* lds) {
  const bf16_t* Q = (const bf16_t*)(opq(P->ws) + OFF_BIG + B_QP); const bf16_t* Kg = (const bf16_t*)(opq(P->ws) + OFF_BIG + B_KK); const bf16_t* VT = (const bf16_t*)(opq(P->ws) + OFF_BIG + B_VT);
  bf16_t* MIX = (bf16_t*)(opq(P->ws) + OFF_U);
  for (int j = obid(); j < 256; j += ogrid()) {
    const int bh = j & 7, pi = j >> 3; const int b = bh >> 2, h = bh & 3;
    attn_unit(lds, Q, Kg, VT, MIX, b, h, 4 * (64 - pi) - 3, 4, 0);
    attn_unit(lds, Q, Kg, VT, MIX, b, h, 4 * (pi + 1) - 3, 4, 1);
    if (pi == 31) attn_unit(lds, Q, Kg, VT, MIX, b, h, 0, 1, 0);
  }
}


#define XB_TMO      128
#define XB_XCNT(j)  (256  + 64 * (j))
#define XB_XSUB(j)  (1280 + 64 * (j))
#define XB_XGEN(j)  (2304 + 64 * (j))
#define XB_TOP      3328
#define XB_TOPGEN   3392
#define XCD_BAR_WORDS 3456
#define XB_SPIN_CAP (1u << 20)
DI unsigned xb_ld(unsigned* p)              { return __hip_atomic_load(p, __ATOMIC_RELAXED, __HIP_MEMORY_SCOPE_AGENT); }
DI unsigned xb_add(unsigned* p, unsigned v) { return __hip_atomic_fetch_add(p, v, __ATOMIC_RELAXED, __HIP_MEMORY_SCOPE_AGENT); }
DI unsigned xb_xcc_id() { return (unsigned)__builtin_amdgcn_s_getreg((3 << 11) | 20) & 0xFu; }
#define XB_SPIN(cond, bar) do { unsigned _sp = 0; while (cond) { __builtin_amdgcn_s_sleep(1); \
    if ((++_sp & 255u) == 0u) { if (xb_ld(&(bar)[XB_TMO])) break; if (_sp > XB_SPIN_CAP) { atomicAdd(&(bar)[XB_TMO], 1u); break; } } } } while (0)
struct XcdBarrier { unsigned* bar; unsigned x; volatile LAS unsigned* st; };
DI XcdBarrier xcd_barrier_post(unsigned* bar, volatile LAS unsigned* st) {
  XcdBarrier b; b.bar = bar; b.x = xb_xcc_id(); b.st = st;
  if (threadIdx.x == 0) (void)xb_add(&bar[XB_XCNT(b.x)], 1u);
  return b;
}
DI void xcd_barrier_complete(unsigned* bar, unsigned x, unsigned& nloc, unsigned& nx) {
  const unsigned Gn = gridDim.x * gridDim.y * gridDim.z;
  unsigned sum, cnt, mine, sp = 0u;
  for (;;) {
    sum = 0u; cnt = 0u; mine = 0u;
#pragma unroll
    for (unsigned j = 0; j < 16; ++j) { const unsigned c = xb_ld(&bar[XB_XCNT(j)]); sum += c; cnt += (c > 0u) ? 1u : 0u; mine = (j == x) ? c : mine; }
    if (sum == Gn) break;
    __builtin_amdgcn_s_sleep(1);
    if ((++sp & 255u) == 0u) { if (xb_ld(&bar[XB_TMO])) break; if (sp > XB_SPIN_CAP) { atomicAdd(&bar[XB_TMO], 1u); break; } }
  }
  nloc = mine > 0u ? mine : 1u; nx = cnt > 0u ? cnt : 1u;
}
DI void xcd_barrier(const XcdBarrier& b) {
  asm volatile("s_waitcnt vmcnt(0)" ::: "memory");
  __syncthreads();
  if (threadIdx.x == 0) {
    unsigned* bar = b.bar;
    __builtin_amdgcn_s_waitcnt(0);
    unsigned nloc = b.st[0], nx = b.st[1];
    if (nloc == 0u) { xcd_barrier_complete(bar, b.x, nloc, nx); b.st[0] = nloc; b.st[1] = nx; }
    const unsigned old = xb_add(&bar[XB_XSUB(b.x)], 1u);
    const unsigned gen = old / nloc;
    if (old + 1u == (gen + 1u) * nloc) {
      __builtin_amdgcn_fence(__ATOMIC_RELEASE, "agent");
      asm volatile("s_waitcnt vmcnt(0)" ::: "memory");
      const unsigned og = xb_add(&bar[XB_TOP], 1u);
      const unsigned tg = og / nx;
      if (og + 1u == (tg + 1u) * nx) xb_add(&bar[XB_TOPGEN], 1u);
      else XB_SPIN(xb_ld(&bar[XB_TOPGEN]) == tg, bar);
      __builtin_amdgcn_fence(__ATOMIC_ACQUIRE, "agent");
      xb_add(&bar[XB_XGEN(b.x)], 1u);
      asm volatile("s_waitcnt vmcnt(0)" ::: "memory");
    } else {
      XB_SPIN(xb_ld(&bar[XB_XGEN(b.x)]) == gen, bar);
      __builtin_amdgcn_fence(__ATOMIC_ACQUIRE, "agent");
      asm volatile("s_waitcnt vmcnt(0)" ::: "memory");
    }
  }
  __syncthreads();
}
DI void tail_fixup(const HMap hm, bf16_t* HB, float* SSQH) {
  const int tid = otid(), wave = tid >> 6, lane = tid & 63;
  for (int r = 32768 + wave; r < MT; r += 8) {
    u32x2* o8 = (u32x2*)(HB + (size_t)r * 1024) + lane; float s = 0.f;
    if (!row_is_pad(r)) { const f32x4* xr = (const f32x4*)hptr(hm, r) + lane;
#pragma unroll
      for (int j = 0; j < 4; ++j) { const f32x4 v = xr[64 * j]; s += (v[0] * v[0] + v[1] * v[1]) + (v[2] * v[2] + v[3] * v[3]); o8[64 * j] = (u32x2){pk2(v[0], v[1]), pk2(v[2], v[3])}; }
    } else {
#pragma unroll
      for (int j = 0; j < 4; ++j) { const unsigned z0 = ouz(); o8[64 * j] = (u32x2){z0, z0}; } }
    s = wave_sum(s);
    if (lane < 16) SSQH[(size_t)r * 16 + lane] = lane == 0 ? s : 0.f;
  }
  asm volatile("s_waitcnt vmcnt(0)" ::: "memory");
}
#define P (kparams())
#define G (ogrid())
#define bid (obid())
template <int layer>
DI void run_layer(LAS unsigned char* lds, const XcdBarrier& xbar) {
    unsigned char* ws = opq(P->ws);
    bf16_t* U = (bf16_t*)(ws + OFF_U); unsigned char* BIG = ws + OFF_BIG;
    float* hside = (float*)(ws + OFF_HSIDE);
    const HMap hm0{P->x, P->meta, 0, nullptr}; const HMap hm1{P->out, hside, 16 * 1024, nullptr}; const HMap hm1b{P->out, hside, 16 * 1024, (const bf16_t*)P->out};
    const HMap hin = layer == 0 ? hm0 : hm1b;
    if ((layer & 1) == 0) {
      const int e = layer >> 1;
      { pg8::Gemm g{layer == 0 ? U : (const bf16_t*)P->out, (const bf16_t*)(ws + OFF_WIN), MT, INP, DM, DM, DM}; pg8::StaticOrder S; S.init(MT, INP, G, bid, 0);
        if (layer > 0) {
          bool own = false; { pg8::Unit uu; for (int i = 0; S.next(i, uu); ++i) own = own || (uu.pm == 128); }
          if (own) tail_fixup(hm1, (bf16_t*)P->out, (float*)(ws + OFF_SSQH));
          __syncthreads(); }
        EpiIn E{BIG, ws, e, layer > 0 ? (const float*)(ws + OFF_SSQH) : nullptr};
        pg8::gemm_phase(lds, g, S, E); }
      conv_bundle(P, layer, CB_UP, lds, 139);
      xcd_barrier(xbar);
      { for (int u = bid; u < 1028; u += G) h1_unit(P, lds, u >> 1, u & 1);
#ifdef DUP_H
        for (int u = bid; u < 1028; u += G) h1_unit(P, lds, u >> 1, u & 1);
#endif
        { pg8::Gemm g{(const bf16_t*)(BIG + B_CQ), (const bf16_t*)(ws + OFF_WQ), MT, 768, 256, 256, 256}; pg8::StaticOrder S; S.init(MT, 768, G, bid, 0);
          EpiQ E{(bf16_t*)(BIG + B_QP), (const float*)(ws + OFF_SSQQ)}; pg8::gemm_phase(lds, g, S, E); }
        { pg8::Gemm g{(const bf16_t*)(BIG + B_CKV), (const bf16_t*)(ws + OFF_WKN), MT, 512, 256, 256, 256}; pg8::StaticOrder S; S.init(MT, 512, G, bid, 125);
          EpiKn E{(bf16_t*)(BIG + B_KK), (const float*)(ws + OFF_SSQKV)}; pg8::gemm_phase(lds, g, S, E); }
        { pg8::Gemm g{(const bf16_t*)(ws + OFF_WV), (const bf16_t*)(BIG + B_CKV), 512, MT, 256, 256, 256}; pg8::StaticOrder S; S.init(512, MT, G, bid, 123);
          EpiVt E{(bf16_t*)(BIG + B_VT), (const float*)(ws + OFF_SSQKV)}; pg8::gemm_phase(lds, g, S, E); } }
      xcd_barrier(xbar);
      { if (G >= 256) { if (bid < 64) phase_h2(P, bid, 64); else phase_qkfinal(P, e, bid - 64, G - 64); }
        else { phase_h2(P, bid, G); phase_qkfinal(P, e, bid, G); } }
      xcd_barrier(xbar);
      { phase_attn(P, lds);
#ifdef DUP_ATTN
        __syncthreads(); phase_attn(P, lds);
#endif
        for (int u = bid; u < 1028; u += G) h3_unit(P, e, lds, u >> 1, u & 1);
#ifdef DUP_H
        __syncthreads(); for (int u = bid; u < 1028; u += G) h3_unit(P, e, lds, u >> 1, u & 1);
#endif
        }
      xcd_barrier(xbar);
      { pg8::Gemm g{U, (const bf16_t*)(ws + OFF_WOUT), 32768, DM, DM, DM, DM}; pg8::StaticOrder S; S.init(32768, DM, G, bid, 0);
        EpiRes E{hin, hm1, nullptr, 0, (bf16_t*)(BIG + B_HB), (float*)(ws + OFF_SSQH), 0}; pg8::gemm_phase(lds, g, S, E); }
      { pg8::Gemm g{U + (size_t)32768 * DM, (const bf16_t*)(ws + OFF_WOUT), 256, DM, 256, DM, DM}; pg8::SplitOrder S; S.init(4, 4, 512u, G, bid, 64);
        EpiResAtomic E{hm1, 32768}; pg8::gemm_phase(lds, g, S, E); }
      xcd_barrier(xbar);
    } else {
      const int o = layer >> 1;
      phase_normpool(hm1b, P->mix_norm + layer * DM, (bf16_t*)BIG, lds);
      xcd_barrier(xbar);
#pragma unroll 1
      for (int gq = 0; gq < 4; ++gq) {
        pg8::Gemm g{(const bf16_t*)BIG + gq * 256, (const bf16_t*)(ws + OFF_WPOOL) + (size_t)gq * 65536, MT, 256, 256, DM, 256}; pg8::StaticOrder S; S.init(MT, 256, G, bid, (127 * gq) % G);
        EpiRes E{hin, hm1, P->pool_scale + o * DM, gq * 256, (bf16_t*)(BIG + B_HB), (float*)(ws + OFF_SSQH), 2}; pg8::gemm_phase(lds, g, S, E); }
      conv_bundle(P, layer, CB_UP, lds, 0);
      xcd_barrier(xbar);
    }
    { pg8::Gemm g{(const bf16_t*)(BIG + B_HB), (const bf16_t*)(ws + OFF_WUP), MT, DFF, DM, DM, DM}; pg8::StaticOrder S; S.init(MT, DFF, G, bid, 0);
      if ((layer & 1) == 0) {
        bool own = false; { pg8::Unit uu; for (int i = 0; S.next(i, uu); ++i) own = own || (uu.pm == 128); }
        if (own) tail_fixup(hm1, (bf16_t*)(BIG + B_HB), (float*)(ws + OFF_SSQH));
        __syncthreads(); }
      EpiUp E{(bf16_t*)BIG, (const float*)(ws + OFF_SSQH)}; pg8::gemm_phase(lds, g, S, E);
    }
    conv_bundle(P, layer, CB_DN, lds, 16);
    if (layer < 3) conv_bundle(P, layer + 1, CB_MIX, lds, 16);
    xcd_barrier(xbar);
    { pg8::Gemm g{(const bf16_t*)BIG, (const bf16_t*)(ws + OFF_WDN), 32768, DM, DFF, DFF, DFF}; pg8::StaticOrder S; S.init(32768, DM, G, bid, 0, 1);
      EpiResB E{(const bf16_t*)(BIG + B_HB), layer < 3 ? hm1b : hm1, layer == 1 ? (float*)(ws + OFF_SSQH) : nullptr}; pg8::gemm_phase(lds, g, S, E); }
    { pg8::Gemm g{(const bf16_t*)BIG + (size_t)32768 * DFF, (const bf16_t*)(ws + OFF_WDN), 256, DM, 256, DFF, DFF}; pg8::SplitOrder S; S.init(4, 16, 512u, G, bid, 0);
      EpiResAtomic E{hm1, 32768}; pg8::gemm_phase(lds, g, S, E); }
    if (layer < 3) xcd_barrier(xbar);
}
__global__ void __launch_bounds__(512, 2) trunk_fwd(Params Parg) {
  extern __shared__ __attribute__((aligned(16))) unsigned char lds_raw[];
  LAS unsigned char* lds = (LAS unsigned char*)lds_raw;
  cg::grid_group grid = cg::this_grid();
  volatile LAS unsigned* xst = (volatile LAS unsigned*)(lds + 131072 + 64);
  if (threadIdx.x < 2) xst[threadIdx.x] = 0u;
  __syncthreads();
  if (blockIdx.x == 0) { unsigned* cw = (unsigned*)(opq(P->ws) + OFF_CTL);
    for (int i = threadIdx.x; i < (int)(CTL_BYTES / 4); i += 512) __hip_atomic_store(cw + i, 0u, __ATOMIC_RELAXED, __HIP_MEMORY_SCOPE_AGENT); }
  phase_tables(P);
  conv_bundle(P, 0, CB_MIX, lds, 0);
  { const HMap hm0{P->x, P->meta, 0, nullptr}; phase_norm(hm0, P->mix_norm, (bf16_t*)(opq(P->ws) + OFF_U)); }
  grid.sync();
  const XcdBarrier xbar = xcd_barrier_post((unsigned*)(opq(P->ws) + OFF_CTL), xst);
  run_layer<0>(lds, xbar);
  run_layer<1>(lds, xbar);
  run_layer<2>(lds, xbar);
  run_layer<3>(lds, xbar);
}

#undef P
#undef G
#undef bid
extern "C" void kernel_launch(void* const* d_in, const int* in_sizes, int n_in, void* d_out, int out_size, void* d_ws, size_t ws_size, hipStream_t stream) {
  static int grid = 0;
  if (grid == 0) {
    if (n_in != 18 || ws_size < WS_NEED) { fprintf(stderr, "kernel_launch: unexpected n_in %d / ws %zu (need %zu)\n", n_in, ws_size, (size_t)WS_NEED); grid = -1; return; }
    int dev = 0, cus = 0, per_cu = 0;
    (void)hipGetDevice(&dev); (void)hipDeviceGetAttribute(&cus, hipDeviceAttributeMultiprocessorCount, dev);
    if (hipFuncSetAttribute((const void*)trunk_fwd, hipFuncAttributeMaxDynamicSharedMemorySize, LDS_BYTES) != hipSuccess) { fprintf(stderr, "kernel_launch: hipFuncSetAttribute failed\n"); grid = -1; return; }
    if (hipOccupancyMaxActiveBlocksPerMultiprocessor(&per_cu, (const void*)trunk_fwd, 512, LDS_BYTES) != hipSuccess || per_cu < 1) { fprintf(stderr, "kernel_launch: occupancy query says %d\n", per_cu); per_cu = 1; }
    (void)hipGetLastError();
    grid = cus > 256 ? 256 : cus;
  }
  if (grid < 0) return;
  Params p{};
  const float** pp = (const float**)&p;
  for (int i = 0; i < 18; ++i) pp[i] = (const float*)d_in[i];
  p.out = (float*)d_out; p.ws = (unsigned char*)d_ws;
  void* args[] = {&p};
  hipError_t e = hipLaunchCooperativeKernel((const void*)trunk_fwd, dim3(grid), dim3(512), args, LDS_BYTES, stream);
  if (e != hipSuccess) fprintf(stderr, "cooperative launch failed: %s (grid %d)\n", hipGetErrorString(e), grid);
}
```

```cpp
#include <hip/hip_runtime.h>
#include <hip/hip_cooperative_groups.h>
#include <cstdio>
#include <cstdint>
#include <cmath>
namespace cg = cooperative_groups;

#define LAS __attribute__((address_space(3)))
#define DI __device__ __forceinline__
typedef unsigned short bf16_t;
typedef short bf16x8 __attribute__((ext_vector_type(8)));
typedef float f32x2 __attribute__((ext_vector_type(2)));
typedef float f32x4 __attribute__((ext_vector_type(4)));
typedef float f32x16 __attribute__((ext_vector_type(16)));
typedef unsigned u32x2 __attribute__((ext_vector_type(2)));
typedef unsigned u32x4 __attribute__((ext_vector_type(4)));
typedef __bf16 bf16v2 __attribute__((ext_vector_type(2)));

constexpr int DM = 1024, NB = 2, SEQ = 16384, NMETA = 16, LSEQ = SEQ + NMETA;
constexpr int LP = 16448;
constexpr int NCH = 257;
constexpr int MR = NB * LP;
constexpr int MT = 33024;
constexpr int DFF = 4096;
constexpr int INC = 2624, INP = 2816;
constexpr float EPS = 1e-6f;
constexpr float NEG_INF = -INFINITY;

constexpr size_t OFF_WUP = 0;
constexpr size_t OFF_WDN = OFF_WUP + (size_t)DFF * DM * 2;
constexpr size_t OFF_WIN = OFF_WDN + (size_t)DFF * DM * 2;
constexpr size_t OFF_WQ = OFF_WIN + (size_t)INP * DM * 2;
constexpr size_t OFF_WKN = OFF_WQ + (size_t)768 * 256 * 2;
constexpr size_t OFF_WV = OFF_WKN + (size_t)512 * 256 * 2;
constexpr size_t OFF_WOUT = OFF_WV + (size_t)512 * 256 * 2;
constexpr size_t OFF_WPOOL = OFF_WOUT + (size_t)DM * DM * 2;
constexpr size_t OFF_COS = OFF_WPOOL + (size_t)4 * 256 * 256 * 2;
constexpr size_t OFF_SIN = OFF_COS + (size_t)LSEQ * 32 * 4;
constexpr size_t OFF_LB = OFF_SIN + (size_t)LSEQ * 32 * 4;
constexpr size_t OFF_HSIDE = OFF_LB + 4 * 512 * 4;
constexpr size_t OFF_SSQQ = OFF_HSIDE + (size_t)2 * 16 * 1024 * 4;
constexpr size_t OFF_SSQKV = OFF_SSQQ + (size_t)MT * 4 * 4;
constexpr size_t OFF_DEC = OFF_SSQKV + (size_t)MT * 4 * 4;
constexpr size_t OFF_SSQH = OFF_DEC + (size_t)514 * 512 * 4;
constexpr size_t OFF_U = ((OFF_SSQH + (size_t)MT * 16 * 4 + 4095) / 4096) * 4096;
constexpr size_t OFF_BIG = OFF_U + (size_t)MT * 1024 * 2;
constexpr size_t B_QH = 0;
constexpr size_t B_VH = B_QH + (size_t)MT * 512 * 2;
constexpr size_t B_GT = B_VH + (size_t)MT * 512 * 2;
constexpr size_t B_LOGF = B_GT + (size_t)MT * 512 * 2;
constexpr size_t B_CQ = B_LOGF + (size_t)MT * 512 * 4;
constexpr size_t B_CKV = B_CQ + (size_t)MT * 256 * 2;
constexpr size_t B_KR = B_CKV + (size_t)MT * 256 * 2;
constexpr size_t B_QP = B_KR + (size_t)MT * 64 * 2;
constexpr size_t B_KK = B_QP + (size_t)MT * 768 * 2;
constexpr size_t B_VT = B_KK + (size_t)MT * 768 * 2;
constexpr size_t B_ST = B_VT + (size_t)NB * 4 * 128 * LP * 2;
constexpr size_t B_END = B_ST + (size_t)514 * 4 * 128 * 128 * 2;
constexpr size_t B_HB = (size_t)300 << 20;
static_assert(B_HB >= (size_t)MT * DFF * 2 && B_HB + (size_t)MT * 1024 * 2 <= B_END, "HB placement");
constexpr size_t OFF_CTL = OFF_BIG + B_END;
constexpr size_t CTL_BYTES = 16384;
constexpr size_t WS_NEED = OFF_CTL + CTL_BYTES;
static_assert(WS_NEED <= 536870912ull, "workspace");
static_assert((size_t)MT * DFF * 2 <= B_END, "A2 fits");
constexpr int LDS_BYTES = 147456;

struct Params {
  const float *x, *meta, *mix_norm, *mlp_norm, *w_mlp_up, *w_mlp_down, *w_in, *hgrn_lb, *hgrn_out_norm, *qa_norm, *kva_norm,
      *w_q_up, *w_kv_up, *q_norm, *k_norm, *w_out, *pool_w, *pool_scale;
  float* out; unsigned char* ws;
};
__constant__ double INVF[32] = {1.0, 0.7498942093324559, 0.5623413251903491, 0.4216965034285822, 0.31622776601683794, 0.23713737056616552, 0.1778279410038923, 0.1333521432163324, 0.1, 0.07498942093324558, 0.05623413251903491, 0.042169650342858224, 0.03162277660168379, 0.023713737056616554, 0.01778279410038923, 0.01333521432163324, 0.01, 0.007498942093324558, 0.005623413251903491, 0.004216965034285823, 0.0031622776601683794, 0.0023713737056616554, 0.0017782794100389228, 0.001333521432163324, 0.001, 0.0007498942093324559, 0.0005623413251903491, 0.00042169650342858224, 0.00031622776601683794, 0.00023713737056616554, 0.00017782794100389227, 0.0001333521432163324};

typedef const __attribute__((address_space(4))) struct Params* KP;
DI KP kparams() { const __attribute__((address_space(4))) unsigned char* p = (const __attribute__((address_space(4))) unsigned char*)__builtin_amdgcn_kernarg_segment_ptr(); asm volatile("" : "+s"(p)); return (KP)p; }
DI int obid() { int t = blockIdx.x; asm volatile("" : "+s"(t)); return t; }
DI int ogrid() { int t = gridDim.x; asm volatile("" : "+s"(t)); return t; }
DI float ozero() { float z = 0.f; asm volatile("" : "+v"(z)); return z; }
DI unsigned ouz() { unsigned z = 0u; asm volatile("" : "+v"(z)); return z; }
DI int otid() { int t = threadIdx.x; asm volatile("" : "+v"(t)); return t; }
DI unsigned char* opq(unsigned char* p) { asm volatile("" : "+s"(p)); return p; }
DI unsigned pk2(float lo, float hi) { f32x2 f = {lo, hi}; bf16v2 b = __builtin_convertvector(f, bf16v2); return __builtin_bit_cast(unsigned, b); }
DI float bflo(unsigned w) { return __uint_as_float(w << 16); }
DI float bfhi(unsigned w) { return __uint_as_float(w & 0xffff0000u); }
DI float bf2f(bf16_t v) { return __uint_as_float(((unsigned)v) << 16); }
DI float fexp(float x) { return __builtin_amdgcn_exp2f(x * 1.44269504088896f); }
DI float flog(float x) { return __builtin_amdgcn_logf(x) * 0.69314718055994f; }
DI float silu(float x) { return x * __builtin_amdgcn_rcpf(1.0f + fexp(-x)); }
DI float wave_sum(float v) {
#pragma unroll
  for (int o = 1; o < 64; o <<= 1) v += __shfl_xor(v, o);
  return v;
}
DI bool row_is_pad(int r) { if (r >= MR) return true; const int pp = r >= LP ? r - LP : r; return pp < 48; }
struct HMap { const float* real; const float* side; int sb; const bf16_t* b16; };
DI bool row_is_main(int r) { if (r >= 32768) return false; const int pp = r >= LP ? r - LP : r; return pp >= 64; }
DI size_t main_off(int r) { return (size_t)r * 1024; }
DI const float* hptr(const HMap& m, int r) { const int b = r >= LP ? 1 : 0; const int pp = r - b * LP;
  return pp < 64 ? m.side + ((size_t)b * m.sb + (size_t)(pp - 48) * 1024) : m.real + ((size_t)(b * SEQ + pp - 64)) * 1024; }
#define MFMA32(a, b, c) __builtin_amdgcn_mfma_f32_32x32x16_bf16((a), (b), (c), 0, 0, 0)
DI int perm32k(int i) { return (i & 0x13) | ((i & 8) >> 1) | ((i & 4) << 1); }
DI bf16x8 pack8(const f32x16& x, int s) { u32x4 p; p.x = pk2(x[8 * s], x[8 * s + 1]); p.y = pk2(x[8 * s + 2], x[8 * s + 3]); p.z = pk2(x[8 * s + 4], x[8 * s + 5]); p.w = pk2(x[8 * s + 6], x[8 * s + 7]); return __builtin_bit_cast(bf16x8, p); }

namespace pg8 {
constexpr int BM = 256, BK = 64, HALF = 128, HTB = HALF * BK * 2, STAGE_BYTES = 8 * HTB, NXCD = 8, WGM = 8;
DI int lds_byte(int r, int c) { const int st = (r >> 4) * 2 + (c >> 5), rr = r & 15, cc = c & 31, ob = rr * 64 + cc * 2; return st * 1024 + (ob ^ (((ob >> 9) & 1) << 5)); }
DI void stage_rc(int b, int& R, int& C) { const int st = b / 1024, sb = b % 1024, swz = sb ^ (((sb >> 9) & 1) << 5); R = (st >> 1) * 16 + swz / 64; C = (st & 1) * 32 + (swz % 64) / 2; }
DI int perm32(int rho) { const int n = rho >> 4, i = rho & 15; return 8 * (i >> 2) + 4 * n + (i & 3); }
struct Unit { int pm, pn; unsigned kb; };
struct Gemm { const bf16_t* A; const bf16_t* Bt; int M, N, K, lda, ldb; };
struct StaticOrder {
  int nM, nN, nwg, G, c, rev;
  DI void init(int M, int N, int G_, int c_, int rot, int rev_ = 0) { nM = M / BM; nN = N / BM; nwg = nM * nN; G = G_; c = (c_ + rot) % G_; rev = rev_; }
  DI bool next(int i, Unit& u) const {
    const long L = (long)i * G + c; if (L >= nwg) return false;
    int wgid = (int)L; { const int q = nwg / NXCD, r = nwg % NXCD, xcd = wgid % NXCD, off = wgid / NXCD; wgid = (xcd < r ? xcd * (q + 1) : r * (q + 1) + (xcd - r) * q) + off; }
    const int nig = WGM * nN, gid = wgid / nig, fm = gid * WGM, gsz = (nM - fm) < WGM ? (nM - fm) : WGM;
    u.pm = fm + ((wgid % nig) % gsz); if (rev) u.pm = nM - 1 - u.pm; u.pn = (wgid % nig) / gsz; u.kb = 0u; return true;
  }
};
struct SplitOrder {
  int nN, total, G, c; unsigned kbytes;
  DI void init(int nN_, int ksplit, unsigned kbytes_, int G_, int c_, int rot) { nN = nN_; total = nN_ * ksplit; kbytes = kbytes_; G = G_; c = (c_ + rot) % G_; }
  DI bool next(int i, Unit& u) const { const int L = i * G + c; if (L >= total) return false; u.pm = 0; u.pn = L % nN; u.kb = (unsigned)(L / nN) * kbytes; return true; }
};
template <class Epi, class Sched>
DI void gemm_phase(LAS unsigned char* lds, const Gemm g, const Sched& S, const Epi& E) {
  const int tid = otid(), wid = __builtin_amdgcn_readfirstlane(tid >> 6), lane = tid & 63, wr = wid >> 2, wc = wid & 3, fr = lane & 15, fq = lane >> 4;
  const int K = g.K, nt = K / BK;
  unsigned voffA[2], voffB[2];
#pragma unroll
  for (int i = 0; i < 2; ++i) { int R, C; stage_rc(tid * 16 + i * 8192, R, C); const int Rb = Epi::PERM ? ((R & ~31) + perm32(R & 31)) : R;
    voffA[i] = (unsigned)(R * g.lda + C) * 2u; voffB[i] = (unsigned)(Rb * g.ldb + C) * 2u; }
  constexpr unsigned kstep = BK * 2;
  const unsigned hstepA = (unsigned)HALF * g.lda * 2u, hstepB = (unsigned)HALF * g.ldb * 2u;
#define tstepA (2 * (size_t)hstepA)
#define tstepB (2 * (size_t)hstepB)
  const unsigned ldsw = (unsigned)wid * 1024u;
  const int aoff = lds_byte(wr * 64 + fr, fq * 8), boff = lds_byte(wc * 32 + fr, fq * 8);
#define PG8_SA(b, h) (((b) * 2 + (h)) * HTB)
#define PG8_SB(b, h) ((4 + (b) * 2 + (h)) * HTB)
#define PG8_STAGE(bufoff, gbase, voff) do { _Pragma("unroll") for (int _i = 0; _i < 2; ++_i) \
        __builtin_amdgcn_global_load_lds((const unsigned*)((const char*)(gbase) + (voff)[_i]), (LAS unsigned*)(lds + (bufoff) + ldsw + _i * 8192), 16, 0, 0); } while (0)
#define PG8_LDA(dst, b, h) do { _Pragma("unroll") for (int m = 0; m < 4; ++m) _Pragma("unroll") for (int k = 0; k < 2; ++k) dst[m][k] = *(const LAS bf16x8*)(lds + PG8_SA(b, h) + aoff + m * 2048 + k * 1024); } while (0)
#define PG8_LDB(dst, b, h) do { _Pragma("unroll") for (int n = 0; n < 2; ++n) _Pragma("unroll") for (int k = 0; k < 2; ++k) dst[n][k] = *(const LAS bf16x8*)(lds + PG8_SB(b, h) + boff + n * 2048 + k * 1024); } while (0)
#define PG8_MMA(ai, bj, At, Bt) do { __builtin_amdgcn_s_setprio(1); _Pragma("unroll") for (int m = 0; m < 4; ++m) _Pragma("unroll") for (int n = 0; n < 2; ++n) _Pragma("unroll") for (int k = 0; k < 2; ++k) \
        acc[ai][bj][m][n] = __builtin_amdgcn_mfma_f32_16x16x32_bf16(Bt[n][k], At[m][k], acc[ai][bj][m][n], 0, 0, 0); __builtin_amdgcn_s_setprio(0); } while (0)
#define PG8_WAIT_V(n) asm volatile("s_waitcnt vmcnt(" #n ")" ::: "memory")
#define PG8_WAIT_L(n) asm volatile("s_waitcnt lgkmcnt(" #n ")" ::: "memory")
#define PG8_BAR __builtin_amdgcn_s_barrier()
#define PG8_SCHED __builtin_amdgcn_sched_barrier(0)
  Unit cur, nxt; int ui = 0;
  if (!S.next(0, cur)) return;
  f32x4 acc[2][2][4][2];
  { const float z0 = ozero();
#pragma unroll
  for (int a = 0; a < 2; ++a)
#pragma unroll
    for (int b = 0; b < 2; ++b)
#pragma unroll
      for (int m = 0; m < 4; ++m)
#pragma unroll
        for (int n = 0; n < 2; ++n) acc[a][b][m][n] = (f32x4){z0, z0, z0, z0}; }
  bf16x8 At[4][2], B0[2][2], B1[2][2];
  const char* cA = (const char*)g.A + (size_t)cur.pm * tstepA + cur.kb; const char* cB = (const char*)g.Bt + (size_t)cur.pn * tstepB + cur.kb;
  PG8_STAGE(PG8_SB(0, 0), cB, voffB); PG8_STAGE(PG8_SB(0, 1), cB + hstepB, voffB); PG8_STAGE(PG8_SA(0, 0), cA, voffA); PG8_STAGE(PG8_SA(0, 1), cA + hstepA, voffA);
  if (wr == 1) PG8_BAR;
  PG8_WAIT_V(2); PG8_BAR;
  PG8_STAGE(PG8_SB(1, 0), cB + kstep, voffB); PG8_STAGE(PG8_SA(1, 0), cA + kstep, voffA); PG8_STAGE(PG8_SB(1, 1), cB + hstepB + kstep, voffB);
  PG8_WAIT_V(6); PG8_BAR;
  for (;;) {
    const bool has_next = S.next(ui + 1, nxt);
    const char* nA = has_next ? (const char*)g.A + (size_t)nxt.pm * tstepA + nxt.kb : cA; const char* nB = has_next ? (const char*)g.Bt + (size_t)nxt.pn * tstepB + nxt.kb : cB;
    for (int t = 0; t < nt; t += 2) {
      const bool last = (t == nt - 2);
      const char* a1 = cA + (size_t)(t + 1) * kstep;
      const char* a2 = last ? nA : cA + (size_t)(t + 2) * kstep; const char* b2 = last ? nB : cB + (size_t)(t + 2) * kstep;
      const char* a3 = a2 + kstep; const char* b3 = b2 + kstep;
      PG8_LDB(B0, 0, 0); PG8_LDB(B1, 0, 1); PG8_SCHED; PG8_LDA(At, 0, 0); PG8_STAGE(PG8_SA(1, 1), a1 + hstepA, voffA);
      PG8_WAIT_V(8); PG8_WAIT_L(0); PG8_BAR; PG8_MMA(0, 0, At, B0); PG8_MMA(0, 1, At, B1); PG8_BAR; PG8_SCHED;
      PG8_LDA(At, 0, 1); PG8_STAGE(PG8_SB(0, 0), b2, voffB); PG8_STAGE(PG8_SB(0, 1), b2 + hstepB, voffB); PG8_STAGE(PG8_SA(0, 0), a2, voffA);
      PG8_WAIT_V(8); PG8_WAIT_L(0); PG8_BAR; PG8_MMA(1, 0, At, B0); PG8_MMA(1, 1, At, B1); PG8_BAR; PG8_SCHED;
      PG8_LDB(B0, 1, 0); PG8_LDB(B1, 1, 1); PG8_SCHED; PG8_LDA(At, 1, 0); PG8_STAGE(PG8_SA(0, 1), a2 + hstepA, voffA);
      PG8_WAIT_V(8); PG8_WAIT_L(0); PG8_BAR; PG8_MMA(0, 0, At, B0); PG8_MMA(0, 1, At, B1); PG8_BAR; PG8_SCHED;
      PG8_LDA(At, 1, 1); PG8_STAGE(PG8_SB(1, 0), b3, voffB); PG8_STAGE(PG8_SB(1, 1), b3 + hstepB, voffB); PG8_STAGE(PG8_SA(1, 0), a3, voffA);
      PG8_WAIT_V(8); PG8_WAIT_L(0); PG8_BAR; PG8_MMA(1, 0, At, B0); PG8_MMA(1, 1, At, B1); PG8_BAR; PG8_SCHED;
    }
    if (wr == 0) PG8_BAR;
    { const int l2 = otid() & 63; E(acc, cur, wr, wc, l2 & 15, l2 >> 4); }
    if (!has_next) break;
    { const float z0 = ozero();
#pragma unroll
    for (int a = 0; a < 2; ++a)
#pragma unroll
      for (int b = 0; b < 2; ++b)
#pragma unroll
        for (int m = 0; m < 4; ++m)
#pragma unroll
          for (int n = 0; n < 2; ++n) acc[a][b][m][n] = (f32x4){z0, z0, z0, z0}; }
    cur = nxt; cA = nA; cB = nB; ++ui;
    if (wr == 1) PG8_BAR;
  }
  PG8_WAIT_V(0);
  PG8_BAR;
#undef tstepA
#undef tstepB
#undef PG8_SA
#undef PG8_SB
#undef PG8_STAGE
#undef PG8_LDA
#undef PG8_LDB
#undef PG8_MMA
#undef PG8_WAIT_V
#undef PG8_WAIT_L
#undef PG8_BAR
#undef PG8_SCHED
}
}
using pg8::Unit;
typedef const f32x4 (&AccRef)[2][2][4][2];

DI u32x4 pack_v8(f32x4 v0, f32x4 v1) { u32x4 w; w.x = pk2(v0[0], v0[1]); w.y = pk2(v0[2], v0[3]); w.z = pk2(v1[0], v1[1]); w.w = pk2(v1[2], v1[3]); return w; }

DI float rstd16(const float* ssq, int row);
struct EpiIn {
  static constexpr bool PERM = true;
  unsigned char* big; unsigned char* wsb; int e; const float* rs16;
  DI void operator()(AccRef acc, const Unit& u, int wr, int wc, int fr, int fq) const {
    bf16_t* const QH = (bf16_t*)(big + B_QH); bf16_t* const VH = (bf16_t*)(big + B_VH); bf16_t* const GT = (bf16_t*)(big + B_GT); bf16_t* const CQ = (bf16_t*)(big + B_CQ);
    bf16_t* const CKV = (bf16_t*)(big + B_CKV); bf16_t* const KR = (bf16_t*)(big + B_KR); float* const LOGF = (float*)(big + B_LOGF);
    float* const SSQQ = (float*)(wsb + OFF_SSQQ); float* const SSQKV = (float*)(wsb + OFF_SSQKV); const float* const ll = (const float*)(wsb + OFF_LB) + e * 512; const float* const l1m = ll + 1024;
    const int pn = u.pn; const int rowb = u.pm * 256 + wr * 64 + fr; const int cw = wc * 32 + 8 * fq;
    if (pn < 2 || (pn >= 4 && pn < 8)) {
      bf16_t* base = pn < 2 ? QH : (pn < 6 ? VH : GT); const bool act = (pn < 2) || (pn >= 6); const int cb = (pn & 1) * 256 + cw;
#pragma unroll
      for (int ai = 0; ai < 2; ++ai)
#pragma unroll
        for (int m = 0; m < 4; ++m) { const int row = rowb + ai * 128 + m * 16; const float rs = rs16 ? rstd16(rs16, row) : 1.0f;
#pragma unroll
          for (int bj = 0; bj < 2; ++bj) { f32x4 v0 = acc[ai][bj][m][0] * rs, v1 = acc[ai][bj][m][1] * rs;
            if (act) {
#pragma unroll
              for (int j = 0; j < 4; ++j) { v0[j] = silu(v0[j]); v1[j] = silu(v1[j]); } }
            *(u32x4*)(base + (size_t)row * 512 + cb + bj * 128) = pack_v8(v0, v1); } }
    } else if (pn < 4) {
#pragma unroll
      for (int bj = 0; bj < 2; ++bj) { const int cb = (pn - 2) * 256 + bj * 128 + cw;
        f32x4 la0 = *(const f32x4*)(ll + cb), la1 = *(const f32x4*)(ll + cb + 4), lm0 = *(const f32x4*)(l1m + cb), lm1 = *(const f32x4*)(l1m + cb + 4);
#pragma unroll
        for (int ai = 0; ai < 2; ++ai)
#pragma unroll
          for (int m = 0; m < 4; ++m) { const int row = rowb + ai * 128 + m * 16; const bool pad = row_is_pad(row); const float rs = rs16 ? rstd16(rs16, row) : 1.0f;
            f32x4 o0, o1;
#pragma unroll
            for (int j = 0; j < 4; ++j) {
              { const float z = acc[ai][bj][m][0][j] * rs; const float ls = fminf(z, 0.f) - flog(1.0f + fexp(-fabsf(z))); const float c = lm0[j] + ls, a = la0[j];
                const float mx = fmaxf(a, c); o0[j] = pad ? 0.f : mx + flog(1.0f + fexp(-fabsf(a - c))); }
              { const float z = acc[ai][bj][m][1][j] * rs; const float ls = fminf(z, 0.f) - flog(1.0f + fexp(-fabsf(z))); const float c = lm1[j] + ls, a = la1[j];
                const float mx = fmaxf(a, c); o1[j] = pad ? 0.f : mx + flog(1.0f + fexp(-fabsf(a - c))); } }
            typedef _Float16 h16x8 __attribute__((ext_vector_type(8)));
            h16x8 hv; hv[0] = (_Float16)o0[0]; hv[1] = (_Float16)o0[1]; hv[2] = (_Float16)o0[2]; hv[3] = (_Float16)o0[3]; hv[4] = (_Float16)o1[0]; hv[5] = (_Float16)o1[1]; hv[6] = (_Float16)o1[2]; hv[7] = (_Float16)o1[3];
            *(h16x8*)((_Float16*)LOGF + (size_t)row * 512 + cb) = hv; } }
    } else if (pn < 10) {
      bf16_t* base = pn == 8 ? CQ : CKV; float* ssq = pn == 8 ? SSQQ : SSQKV;
#pragma unroll
      for (int ai = 0; ai < 2; ++ai)
#pragma unroll
        for (int m = 0; m < 4; ++m) { const int row = rowb + ai * 128 + m * 16; float s = 0.f; const float rs = rs16 ? rstd16(rs16, row) : 1.0f;
#pragma unroll
          for (int bj = 0; bj < 2; ++bj) { const f32x4 v0 = acc[ai][bj][m][0] * rs, v1 = acc[ai][bj][m][1] * rs;
            s += (v0[0] * v0[0] + v0[1] * v0[1]) + (v0[2] * v0[2] + v0[3] * v0[3]) + (v1[0] * v1[0] + v1[1] * v1[1]) + (v1[2] * v1[2] + v1[3] * v1[3]);
            *(u32x4*)(base + (size_t)row * 256 + cw + bj * 128) = pack_v8(v0, v1); }
          s += __shfl_xor(s, 16); s += __shfl_xor(s, 32);
          if (fq == 0) ssq[(size_t)row * 4 + wc] = s; }
    } else {
      if (wc < 2) {
#pragma unroll
        for (int ai = 0; ai < 2; ++ai)
#pragma unroll
          for (int m = 0; m < 4; ++m) { const int row = rowb + ai * 128 + m * 16; const float rs = rs16 ? rstd16(rs16, row) : 1.0f;
            *(u32x4*)(KR + (size_t)row * 64 + cw) = pack_v8(acc[ai][0][m][0] * rs, acc[ai][0][m][1] * rs); } }
    }
  }
};
DI float rstd4(const float* ssq, int row, float invn) { const f32x4 s = *(const f32x4*)(ssq + (size_t)row * 4); return __builtin_amdgcn_rsqf(((s[0] + s[1]) + (s[2] + s[3])) * invn + EPS); }
DI float rstd16(const float* ssq, int row) { const f32x4* p = (const f32x4*)(ssq + (size_t)row * 16); const f32x4 a = p[0], b = p[1], c = p[2], d = p[3];
  return __builtin_amdgcn_rsqf((((a[0] + a[1]) + (a[2] + a[3])) + ((b[0] + b[1]) + (b[2] + b[3])) + ((c[0] + c[1]) + (c[2] + c[3])) + ((d[0] + d[1]) + (d[2] + d[3]))) * (1.0f / 1024.0f) + EPS); }
struct EpiQ {
  static constexpr bool PERM = true; bf16_t* QP; const float* ssq;
  DI void operator()(AccRef acc, const Unit& u, int wr, int wc, int fr, int fq) const {
    const int rowb = u.pm * 256 + wr * 64 + fr; const int cb = u.pn * 256 + wc * 32 + 8 * fq;
#pragma unroll
    for (int ai = 0; ai < 2; ++ai)
#pragma unroll
      for (int m = 0; m < 4; ++m) { const int row = rowb + ai * 128 + m * 16; const float rs = rstd4(ssq, row, 1.0f / 256.0f);
#pragma unroll
        for (int bj = 0; bj < 2; ++bj) *(u32x4*)(QP + (size_t)row * 768 + cb + bj * 128) = pack_v8(acc[ai][bj][m][0] * rs, acc[ai][bj][m][1] * rs); }
  }
};
struct EpiKn {
  static constexpr bool PERM = true; bf16_t* KK; const float* ssq;
  DI void operator()(AccRef acc, const Unit& u, int wr, int wc, int fr, int fq) const {
    const int rowb = u.pm * 256 + wr * 64 + fr; const int d0 = wc * 32 + 8 * fq;
#pragma unroll
    for (int ai = 0; ai < 2; ++ai)
#pragma unroll
      for (int m = 0; m < 4; ++m) { const int row = rowb + ai * 128 + m * 16; const float rs = rstd4(ssq, row, 1.0f / 256.0f);
#pragma unroll
        for (int bj = 0; bj < 2; ++bj) *(u32x4*)(KK + (size_t)row * 768 + (u.pn * 2 + bj) * 192 + d0) = pack_v8(acc[ai][bj][m][0] * rs, acc[ai][bj][m][1] * rs); }
  }
};
struct EpiVt {
  static constexpr bool PERM = true; bf16_t* VT; const float* ssq;
  DI void operator()(AccRef acc, const Unit& u, int wr, int wc, int fr, int fq) const {
    const int fb = u.pm * 256 + wr * 64 + fr;
#pragma unroll
    for (int bj = 0; bj < 2; ++bj) { const int t0 = u.pn * 256 + bj * 128 + wc * 32 + 8 * fq;
      if (t0 >= MR) continue;
      float rs[8];
#pragma unroll
      for (int j = 0; j < 8; ++j) rs[j] = rstd4(ssq, t0 + j, 1.0f / 256.0f);
      const int b = t0 >= LP ? 1 : 0; const int pp = t0 - b * LP;
#pragma unroll
      for (int ai = 0; ai < 2; ++ai)
#pragma unroll
        for (int m = 0; m < 4; ++m) { const int f = fb + ai * 128 + m * 16; const int hd = f >> 7, d = f & 127;
          f32x4 v0 = acc[ai][bj][m][0], v1 = acc[ai][bj][m][1];
#pragma unroll
          for (int j = 0; j < 4; ++j) { v0[j] *= rs[j]; v1[j] *= rs[4 + j]; }
          *(u32x4*)(VT + ((size_t)((b * 4 + hd) * 128 + d)) * LP + pp) = pack_v8(v0, v1); } }
  }
};
struct EpiUp {
  static constexpr bool PERM = true; bf16_t* A2; const float* SSQH;
  DI void operator()(AccRef acc, const Unit& u, int wr, int wc, int fr, int fq) const {
    const int rowb = u.pm * 256 + wr * 64 + fr; const int cb = u.pn * 256 + wc * 32 + 8 * fq;
#pragma unroll
    for (int ai = 0; ai < 2; ++ai)
#pragma unroll
      for (int m = 0; m < 4; ++m) { const int row = rowb + ai * 128 + m * 16; const float rs = rstd16(SSQH, row);
#pragma unroll
        for (int bj = 0; bj < 2; ++bj) { f32x4 v0 = acc[ai][bj][m][0], v1 = acc[ai][bj][m][1];
#pragma unroll
          for (int j = 0; j < 4; ++j) { const float a = fmaxf(v0[j], 0.f) * rs, b = fmaxf(v1[j], 0.f) * rs; v0[j] = a * a; v1[j] = b * b; }
          *(u32x4*)(A2 + (size_t)row * DFF + cb + bj * 128) = pack_v8(v0, v1); } }
  }
};
struct EpiRes {
  static constexpr bool PERM = true; HMap in; HMap outm; const float* scale; int coff; bf16_t* HB; float* SSQH; int wmode;
  DI void operator()(AccRef acc, const Unit& u, int wr, int wc, int fr, int fq) const {
    const bool w32 = (wmode == 1) || (wmode == 2 && u.pm == 128);
    const int rowb = u.pm * 256 + wr * 64 + fr; const int cb = coff + u.pn * 256 + wc * 32 + 8 * fq;
    f32x4 sc[2][2];
#pragma unroll
    for (int bj = 0; bj < 2; ++bj)
#pragma unroll
      for (int n = 0; n < 2; ++n) sc[bj][n] = scale ? *(const f32x4*)(scale + cb + bj * 128 + n * 4) : (f32x4){1.f, 1.f, 1.f, 1.f};
#pragma unroll
    for (int ai = 0; ai < 2; ++ai)
#pragma unroll
      for (int m = 0; m < 4; ++m) { const int row = rowb + ai * 128 + m * 16;
        const bool pad = row_is_pad(row); float ss = 0.f;
        if (!pad) {
          const bool inb = in.b16 && row_is_main(row);
          const float* ip = hptr(in, row) + cb; float* op = (float*)hptr(outm, row) + cb; const bf16_t* ib = in.b16 + main_off(row) + cb;
#pragma unroll
          for (int bj = 0; bj < 2; ++bj) {
            f32x4 b0, b1;
            if (inb) { const u32x4 w = *(const u32x4*)(ib + bj * 128); b0 = (f32x4){bflo(w.x), bfhi(w.x), bflo(w.y), bfhi(w.y)}; b1 = (f32x4){bflo(w.z), bfhi(w.z), bflo(w.w), bfhi(w.w)}; }
            else { b0 = *(const f32x4*)(ip + bj * 128); b1 = *(const f32x4*)(ip + bj * 128 + 4); }
            const f32x4 o0 = b0 + acc[ai][bj][m][0] * sc[bj][0], o1 = b1 + acc[ai][bj][m][1] * sc[bj][1];
            if (w32) { *(f32x4*)(op + bj * 128) = o0; *(f32x4*)(op + bj * 128 + 4) = o1; }
            if (HB) { ss += ((o0[0] * o0[0] + o0[1] * o0[1]) + (o0[2] * o0[2] + o0[3] * o0[3])) + ((o1[0] * o1[0] + o1[1] * o1[1]) + (o1[2] * o1[2] + o1[3] * o1[3]));
              *(u32x4*)(HB + (size_t)row * 1024 + cb + bj * 128) = pack_v8(o0, o1); } }
        } else if (HB) {
#pragma unroll
          for (int bj = 0; bj < 2; ++bj) *(u32x4*)(HB + (size_t)row * 1024 + cb + bj * 128) = (u32x4){0u, 0u, 0u, 0u};
        }
        if (HB) { ss += __shfl_xor(ss, 16); ss += __shfl_xor(ss, 32); if (fq == 0) SSQH[(size_t)row * 16 + ((coff >> 8) + u.pn) * 4 + wc] = ss; }
      }
  }
};
struct EpiResB {
  static constexpr bool PERM = true; const bf16_t* HB; HMap outm; float* SSQ;
  DI void operator()(AccRef acc, const Unit& u, int wr, int wc, int fr, int fq) const {
    const int rowb = u.pm * 256 + wr * 64 + fr; const int cb = u.pn * 256 + wc * 32 + 8 * fq;
#pragma unroll
    for (int ai = 0; ai < 2; ++ai)
#pragma unroll
      for (int m = 0; m < 4; ++m) { const int row = rowb + ai * 128 + m * 16;
        if (row_is_pad(row)) { if (SSQ && fq == 0) SSQ[(size_t)row * 16 + u.pn * 4 + wc] = 0.f; continue; }
        float ss = 0.f;
        const bool outb = outm.b16 && row_is_main(row);
        float* op = (float*)hptr(outm, row) + cb; const bf16_t* bp = HB + (size_t)row * 1024 + cb; bf16_t* ob = (bf16_t*)outm.b16 + main_off(row) + cb;
#pragma unroll
        for (int bj = 0; bj < 2; ++bj) { const u32x4 b = *(const u32x4*)(bp + bj * 128);
          const f32x4 b0 = {bflo(b.x), bfhi(b.x), bflo(b.y), bfhi(b.y)}, b1 = {bflo(b.z), bfhi(b.z), bflo(b.w), bfhi(b.w)};
          const f32x4 o0 = b0 + acc[ai][bj][m][0], o1 = b1 + acc[ai][bj][m][1];
          if (outb) *(u32x4*)(ob + bj * 128) = pack_v8(o0, o1);
          else { *(f32x4*)(op + bj * 128) = o0; *(f32x4*)(op + bj * 128 + 4) = o1; if (SSQ) *(u32x4*)(ob + bj * 128) = pack_v8(o0, o1); }
          if (SSQ) ss += ((o0[0] * o0[0] + o0[1] * o0[1]) + (o0[2] * o0[2] + o0[3] * o0[3])) + ((o1[0] * o1[0] + o1[1] * o1[1]) + (o1[2] * o1[2] + o1[3] * o1[3])); }
        if (SSQ) { ss += __shfl_xor(ss, 16); ss += __shfl_xor(ss, 32); if (fq == 0) SSQ[(size_t)row * 16 + u.pn * 4 + wc] = ss; } }
  }
};
struct EpiResAtomic {
  static constexpr bool PERM = true; HMap outm; int rowoff;
  DI void operator()(AccRef acc, const Unit& u, int wr, int wc, int fr, int fq) const {
    const int rowb = rowoff + u.pm * 256 + wr * 64 + fr; const int cb = u.pn * 256 + wc * 32 + 8 * fq;
#pragma unroll
    for (int ai = 0; ai < 2; ++ai)
#pragma unroll
      for (int m = 0; m < 4; ++m) { const int row = rowb + ai * 128 + m * 16;
        if (row_is_pad(row)) continue;
        float* op = (float*)hptr(outm, row) + cb;
#pragma unroll
        for (int bj = 0; bj < 2; ++bj)
#pragma unroll
          for (int n = 0; n < 2; ++n)
#pragma unroll
            for (int j = 0; j < 4; ++j) __hip_atomic_fetch_add(op + bj * 128 + n * 4 + j, acc[ai][bj][m][n][j], __ATOMIC_RELAXED, __HIP_MEMORY_SCOPE_AGENT); }
  }
};


DI void transpose_item(const float* W, int pitch, int N, bf16_t* WT, int dpitch, const float* kscale, LAS float* scr, int item, int lane) {
  const int nblk = N / 32, kb = item / nblk, nb = item % nblk, k0 = 64 * kb, n0 = 32 * nb;
#pragma unroll 8
  for (int i = 0; i < 32; ++i) { const int kk = 2 * i + (lane >> 5); scr[kk * 33 + (lane & 31)] = W[(size_t)(k0 + kk) * pitch + n0 + (lane & 31)]; }
  asm volatile("s_waitcnt lgkmcnt(0)" ::: "memory");
  const int c = lane & 7;
  float ks[8];
#pragma unroll
  for (int i = 0; i < 8; ++i) ks[i] = kscale ? kscale[k0 + 8 * c + i] : 1.0f;
#pragma unroll
  for (int j = 0; j < 4; ++j) { const int n = (lane >> 3) + 8 * j; const LAS float* s = scr + (8 * c) * 33 + n;
    u32x4 o; o.x = pk2(s[0 * 33] * ks[0], s[1 * 33] * ks[1]); o.y = pk2(s[2 * 33] * ks[2], s[3 * 33] * ks[3]); o.z = pk2(s[4 * 33] * ks[4], s[5 * 33] * ks[5]); o.w = pk2(s[6 * 33] * ks[6], s[7 * 33] * ks[7]);
    *(u32x4*)(WT + (size_t)(n0 + n) * dpitch + k0 + 8 * c) = o; }
  asm volatile("s_waitcnt lgkmcnt(0)" ::: "memory");
}
DI void conv_job(const float* W, int pitch, int K, int N, bf16_t* WT, int dpitch, const float* kscale, LAS float* scr, int gw, int NGW, int lane) {
  const int items = (K / 64) * (N / 32);
  for (int it = gw; it < items; it += NGW) transpose_item(W, pitch, N, WT, dpitch, kscale, scr, it, lane);
}
enum { CB_UP = 0, CB_DN = 1, CB_MIX = 2 };
DI int grab_item(unsigned* ctr, int lane) { int v = 0; if (lane == 0) v = (int)__hip_atomic_fetch_add(ctr, 1u, __ATOMIC_RELAXED, __HIP_MEMORY_SCOPE_AGENT); return __builtin_amdgcn_readfirstlane(v); }
DI void conv_bundle(KP P, int layer, int kind, LAS unsigned char* lds, int wg_lo) {
  const int tid = otid(), wave = tid >> 6, lane = tid & 63;
  const int nb = ogrid(), b0 = obid(); const int lo = wg_lo < nb ? wg_lo : 0;
  if (b0 < lo) return;
  const int gw = (b0 - lo) * 8 + wave, NGW = (nb - lo) * 8;
  LAS float* scr = (LAS float*)(lds + wave * 8448);
  unsigned char* ws = opq(P->ws);
  const int e = layer >> 1;
  const int total = kind != CB_MIX ? 2048 : ((layer & 1) ? 128 : 2048 + 384);
  for (int it = gw; it < total; it += NGW) {
    if (kind == CB_UP) transpose_item(P->w_mlp_up + (size_t)layer * DM * DFF, DFF, DFF, (bf16_t*)(ws + OFF_WUP), DM, P->mlp_norm + layer * DM, scr, it, lane);
    else if (kind == CB_DN) transpose_item(P->w_mlp_down + (size_t)layer * DM * DFF, DM, DM, (bf16_t*)(ws + OFF_WDN), DFF, nullptr, scr, it, lane);
    else if (layer & 1) transpose_item(P->pool_w + (size_t)(e * 4 + (it >> 5)) * 65536, 256, 256, (bf16_t*)(ws + OFF_WPOOL) + (size_t)(it >> 5) * 65536, 256, nullptr, scr, it & 31, lane);
    else if (it < 1312) transpose_item(P->w_in + (size_t)e * DM * INC, INC, INC, (bf16_t*)(ws + OFF_WIN), DM, layer == 2 ? P->mix_norm + layer * DM : nullptr, scr, it, lane);
    else if (it < 1408) transpose_item(P->w_q_up + (size_t)e * 256 * 768, 768, 768, (bf16_t*)(ws + OFF_WQ), 256, P->qa_norm + e * 256, scr, it - 1312, lane);
    else if (it < 1472) { const int j = it - 1408, h = j >> 4; transpose_item(P->w_kv_up + (size_t)e * 256 * 1024 + h * 256, 1024, 128, (bf16_t*)(ws + OFF_WKN) + (size_t)h * 128 * 256, 256, P->kva_norm + e * 256, scr, j & 15, lane); }
    else if (it < 1536) { const int j = it - 1472, h = j >> 4; transpose_item(P->w_kv_up + (size_t)e * 256 * 1024 + h * 256 + 128, 1024, 128, (bf16_t*)(ws + OFF_WV) + (size_t)h * 128 * 256, 256, P->kva_norm + e * 256, scr, j & 15, lane); }
    else if (it < 2048) transpose_item(P->w_out + (size_t)e * DM * DM, DM, DM, (bf16_t*)(ws + OFF_WOUT), DM, nullptr, scr, it - 1536, lane);
    else { const unsigned z0 = ouz(); *(u32x4*)(ws + OFF_WIN + (size_t)INC * DM * 2 + (size_t)(it - 2048) * 1024 + lane * 16) = (u32x4){z0, z0, z0, z0}; }
  }
}
DI void phase_tables(KP P) {
  const int gt = obid() * 512 + otid(), NT = ogrid() * 512;
  float* cosT = (float*)(opq(P->ws) + OFF_COS); float* sinT = (float*)(opq(P->ws) + OFF_SIN);
  for (int idx = gt; idx < LSEQ * 32; idx += NT) { const int p = idx >> 5, i = idx & 31;
    double rev = (double)p * INVF[i] * 0.15915494309189535; rev -= rint(rev); const float fr = (float)rev;
    cosT[idx] = __builtin_amdgcn_cosf(fr); sinT[idx] = __builtin_amdgcn_sinf(fr); }
  float* lb = (float*)(opq(P->ws) + OFF_LB);
  for (int idx = gt; idx < 512; idx += NT) { const float x0 = P->hgrn_lb[idx], x1 = P->hgrn_lb[512 + idx]; const float d = x0 - x1;
    const float spd = fmaxf(d, 0.f) + log1pf(expf(-fabsf(d))), spn = fmaxf(-d, 0.f) + log1pf(expf(-fabsf(d)));
    lb[idx] = NEG_INF; lb[1024 + idx] = 0.f; lb[512 + idx] = -spd; lb[1536 + idx] = -spn; }
  { const f32x4* xs = (const f32x4*)(P->x + (size_t)32640 * 1024); f32x4* od = (f32x4*)(P->out + (size_t)32640 * 1024);
    for (int idx = gt; idx < 128 * 256; idx += NT) od[idx] = xs[idx]; }
  { u32x4* zb = (u32x4*)P->out; const unsigned z0 = ouz();
    for (int idx = gt; idx < 96 * 128; idx += NT) { const int rr = idx >> 7; const int row = rr < 48 ? rr : LP + rr - 48; zb[(size_t)row * 128 + (idx & 127)] = (u32x4){z0, z0, z0, z0}; } }
  float* hs = (float*)(opq(P->ws) + OFF_HSIDE);
  for (int idx = gt; idx < 2 * 16 * 1024; idx += NT) hs[idx] = P->meta[idx & 16383];
}
DI void phase_norm(const HMap hm, const float* g, bf16_t* U) {
  const int tid = otid(), wave = tid >> 6, lane = tid & 63; const int gw = obid() * 8 + wave, NGW = ogrid() * 8;
  f32x4 gv[4];
#pragma unroll
  for (int j = 0; j < 4; ++j) gv[j] = *(const f32x4*)(g + 4 * lane + 256 * j);
  for (int rb = gw * 2; rb < MT; rb += NGW * 2) {
    f32x4 v[2][4]; bool pad[2];
#pragma unroll
    for (int q = 0; q < 2; ++q) { const int r = rb + q; pad[q] = row_is_pad(r);
      if (!pad[q]) {
        if (hm.b16 && row_is_main(r)) { const u32x2* xb = (const u32x2*)(hm.b16 + main_off(r)) + lane;
#pragma unroll
          for (int j = 0; j < 4; ++j) { const u32x2 w = xb[64 * j]; v[q][j] = (f32x4){bflo(w.x), bfhi(w.x), bflo(w.y), bfhi(w.y)}; } }
        else { const f32x4* xr = (const f32x4*)hptr(hm, r) + lane;
#pragma unroll
          for (int j = 0; j < 4; ++j) v[q][j] = xr[64 * j]; } }
      else {
#pragma unroll
        for (int j = 0; j < 4; ++j) v[q][j] = (f32x4){0.f, 0.f, 0.f, 0.f}; } }
#pragma unroll
    for (int q = 0; q < 2; ++q) { const int r = rb + q; u32x2* o8 = (u32x2*)(U + (size_t)r * 1024) + lane;
      float s = 0.f;
#pragma unroll
      for (int j = 0; j < 4; ++j) s += (v[q][j][0] * v[q][j][0] + v[q][j][1] * v[q][j][1]) + (v[q][j][2] * v[q][j][2] + v[q][j][3] * v[q][j][3]);
      const float rstd = pad[q] ? 0.f : __builtin_amdgcn_rsqf(wave_sum(s) * (1.0f / 1024.0f) + EPS);
#pragma unroll
      for (int j = 0; j < 4; ++j) { const f32x4 y = v[q][j] * rstd * gv[j]; o8[64 * j] = (u32x2){pk2(y[0], y[1]), pk2(y[2], y[3])}; } }
  }
}
DI void acc8(float (&sum)[8], const u32x4 v, float sgn) {
  sum[0] += sgn * bflo(v.x); sum[1] += sgn * bfhi(v.x); sum[2] += sgn * bflo(v.y); sum[3] += sgn * bfhi(v.y);
  sum[4] += sgn * bflo(v.z); sum[5] += sgn * bfhi(v.z); sum[6] += sgn * bflo(v.w); sum[7] += sgn * bfhi(v.w);
}
template <int W>
DI void pool_item(const bf16_t* U, bf16_t* PD, int r0, int col) {
  const unsigned z0 = ouz();
  if (row_is_pad(r0)) {
#pragma unroll
    for (int t = 0; t < 8; ++t) *(u32x4*)(PD + (size_t)(r0 + t) * 1024 + col) = (u32x4){z0, z0, z0, z0};
    return; }
  u32x4 v[8 + W - 1];
#pragma unroll
  for (int i = 0; i < 8 + W - 1; ++i) { const int rr = r0 - (W - 1) + i; v[i] = rr >= 0 ? *(const u32x4*)(U + (size_t)rr * 1024 + col) : (u32x4){z0, z0, z0, z0}; }
  const int pp0 = r0 >= LP ? r0 - LP : r0; const int p0 = pp0 - 48;
  float sum[8] = {0.f, 0.f, 0.f, 0.f, 0.f, 0.f, 0.f, 0.f};
#pragma unroll
  for (int i = 0; i < W - 1; ++i) acc8(sum, v[i], 1.0f);
#pragma unroll
  for (int t = 0; t < 8; ++t) {
    acc8(sum, v[W - 1 + t], 1.0f);
    const int cnt = (p0 + t + 1) < W ? (p0 + t + 1) : W; const float ic = 1.0f / (float)cnt; const u32x4 own = v[W - 1 + t];
    u32x4 o;
    o.x = pk2(sum[0] * ic - bflo(own.x), sum[1] * ic - bfhi(own.x)); o.y = pk2(sum[2] * ic - bflo(own.y), sum[3] * ic - bfhi(own.y));
    o.z = pk2(sum[4] * ic - bflo(own.z), sum[5] * ic - bfhi(own.z)); o.w = pk2(sum[6] * ic - bflo(own.w), sum[7] * ic - bfhi(own.w));
    *(u32x4*)(PD + (size_t)(r0 + t) * 1024 + col) = o;
    acc8(sum, v[t], -1.0f);
  }
}
DI void phase_pooldiff(const bf16_t* U, bf16_t* PD) {
  const int gt = obid() * 512 + otid(), NT = ogrid() * 512;
  for (int idx = gt; idx < (MT / 8) * 128; idx += NT) { const int rb = idx >> 7, ch = idx & 127, col = ch * 8, g = ch >> 5;
    if (g == 0) pool_item<2>(U, PD, rb * 8, col); else if (g == 1) pool_item<4>(U, PD, rb * 8, col); else if (g == 2) pool_item<8>(U, PD, rb * 8, col); else pool_item<16>(U, PD, rb * 8, col); }
}
template <int W>
DI void normpool_item(const LAS unsigned char* ul, bf16_t* PD, int r0, int rg, int col) {
  u32x4 v[8 + W - 1];
#pragma unroll
  for (int i = 0; i < 8 + W - 1; ++i) v[i] = *(const LAS u32x4*)(ul + (15 + rg * 8 - (W - 1) + i) * 2048 + col * 2);
  float sum[8] = {0.f, 0.f, 0.f, 0.f, 0.f, 0.f, 0.f, 0.f};
#pragma unroll
  for (int i = 0; i < W - 1; ++i) acc8(sum, v[i], 1.0f);
#pragma unroll
  for (int t = 0; t < 8; ++t) {
    acc8(sum, v[W - 1 + t], 1.0f);
    const int r = r0 + rg * 8 + t; const bool pad = row_is_pad(r); const int pp = r >= LP ? r - LP : r; const int p = pp - 48;
    const int cnt = (p + 1) < W ? (p + 1) : W; const float ic = pad ? 0.f : 1.0f / (float)cnt; const u32x4 own = v[W - 1 + t];
    u32x4 o;
    o.x = pk2(sum[0] * ic - bflo(own.x), sum[1] * ic - bfhi(own.x)); o.y = pk2(sum[2] * ic - bflo(own.y), sum[3] * ic - bfhi(own.y));
    o.z = pk2(sum[4] * ic - bflo(own.z), sum[5] * ic - bfhi(own.z)); o.w = pk2(sum[6] * ic - bflo(own.w), sum[7] * ic - bfhi(own.w));
    *(u32x4*)(PD + (size_t)r * 1024 + col) = o;
    acc8(sum, v[t], -1.0f);
  }
}
DI void phase_normpool(const HMap hm, const float* g, bf16_t* PD, LAS unsigned char* lds) {
  const int tid = otid(), wave = tid >> 6, lane = tid & 63;
  f32x4 gv[4];
#pragma unroll
  for (int j = 0; j < 4; ++j) gv[j] = *(const f32x4*)(g + 4 * lane + 256 * j);
  for (int blk = obid(); blk < MT / 48; blk += ogrid()) {
    const int r0 = blk * 48;
    for (int lb = wave; lb < 63; lb += 16) {
      f32x4 v[2][4]; bool pad[2];
#pragma unroll
      for (int q = 0; q < 2; ++q) { const int li = lb + 8 * q; const int r = r0 - 15 + li; pad[q] = (li >= 63) || (r < 0) || row_is_pad(r);
        if (!pad[q]) {
          if (hm.b16 && row_is_main(r)) { const u32x2* xb = (const u32x2*)(hm.b16 + main_off(r)) + lane;
#pragma unroll
            for (int j = 0; j < 4; ++j) { const u32x2 w = xb[64 * j]; v[q][j] = (f32x4){bflo(w.x), bfhi(w.x), bflo(w.y), bfhi(w.y)}; } }
          else { const f32x4* xr = (const f32x4*)hptr(hm, r) + lane;
#pragma unroll
            for (int j = 0; j < 4; ++j) v[q][j] = xr[64 * j]; } }
        else {
#pragma unroll
          for (int j = 0; j < 4; ++j) v[q][j] = (f32x4){0.f, 0.f, 0.f, 0.f}; } }
#pragma unroll
      for (int q = 0; q < 2; ++q) { const int li = lb + 8 * q;
        float s_ = 0.f;
#pragma unroll
        for (int j = 0; j < 4; ++j) s_ += (v[q][j][0] * v[q][j][0] + v[q][j][1] * v[q][j][1]) + (v[q][j][2] * v[q][j][2] + v[q][j][3] * v[q][j][3]);
        const float rstd = pad[q] ? 0.f : __builtin_amdgcn_rsqf(wave_sum(s_) * (1.0f / 1024.0f) + EPS);
        if (li < 63) { LAS u32x2* o8 = (LAS u32x2*)(lds + li * 2048) + lane;
#pragma unroll
          for (int j = 0; j < 4; ++j) { const f32x4 y = v[q][j] * rstd * gv[j]; o8[64 * j] = (u32x2){pk2(y[0], y[1]), pk2(y[2], y[3])}; } } }
    }
    __syncthreads();
    for (int item = tid; item < 768; item += 512) { const int rg = item >> 7, ch = item & 127, col = ch * 8, gq = ch >> 5;
      if (gq == 0) normpool_item<2>(lds, PD, r0, rg, col); else if (gq == 1) normpool_item<4>(lds, PD, r0, rg, col); else if (gq == 2) normpool_item<8>(lds, PD, r0, rg, col); else normpool_item<16>(lds, PD, r0, rg, col); }
    __syncthreads();
  }
}
DI void phase_qkfinal(KP P, int e, int wg, int nwg) {
  const int tid = otid(), wave = tid >> 6, lane = tid & 63; const int gw = wg * 8 + wave, NGW = nwg * 8;
  const int hd = lane >> 4, li = lane & 15;
  bf16_t* QP = (bf16_t*)(opq(P->ws) + OFF_BIG + B_QP); bf16_t* KK = (bf16_t*)(opq(P->ws) + OFF_BIG + B_KK); const bf16_t* KR = (const bf16_t*)(opq(P->ws) + OFF_BIG + B_KR);
  const float* cosT = (const float*)(opq(P->ws) + OFF_COS); const float* sinT = (const float*)(opq(P->ws) + OFF_SIN);
  const float* qg = P->q_norm + e * 192; const float* kg = P->k_norm + e * 192;
  float qgn[8], kgn[8];
#pragma unroll
  for (int j = 0; j < 8; ++j) { qgn[j] = qg[8 * li + j]; kgn[j] = kg[8 * li + j]; }
  const float qg1a = qg[128 + 2 * li], qg1b = qg[129 + 2 * li], qg2a = qg[160 + 2 * li], qg2b = qg[161 + 2 * li];
  const float kg1a = kg[128 + 2 * li], kg1b = kg[129 + 2 * li], kg2a = kg[160 + 2 * li], kg2b = kg[161 + 2 * li];
  const float SCQ = 0.07216878364870322f * 1.44269504088896f;
  for (int rb = gw * 2; rb < MR; rb += NGW * 2) {
    f32x2 cs[2], sn[2]; u32x4 qn[2], kn[2]; unsigned q1[2], q2[2], k1[2], k2[2];
#pragma unroll
    for (int q = 0; q < 2; ++q) { const int r = rb + q; const int pp = r >= LP ? r - LP : r; const int p = pp >= 48 ? pp - 48 : 0;
      cs[q] = *(const f32x2*)(cosT + p * 32 + 2 * li); sn[q] = *(const f32x2*)(sinT + p * 32 + 2 * li);
      const bf16_t* qp = QP + (size_t)r * 768 + hd * 192; const bf16_t* kp = KK + (size_t)r * 768 + hd * 192;
      qn[q] = *(const u32x4*)(qp + 8 * li); q1[q] = *(const unsigned*)(qp + 128 + 2 * li); q2[q] = *(const unsigned*)(qp + 160 + 2 * li);
      kn[q] = *(const u32x4*)(kp + 8 * li); k1[q] = *(const unsigned*)(KR + (size_t)r * 64 + 2 * li); k2[q] = *(const unsigned*)(KR + (size_t)r * 64 + 32 + 2 * li); }
#pragma unroll
    for (int q = 0; q < 2; ++q) { const int r = rb + q;
      { bf16_t* qp = QP + (size_t)r * 768 + hd * 192;
        float x[8] = {bflo(qn[q].x), bfhi(qn[q].x), bflo(qn[q].y), bfhi(qn[q].y), bflo(qn[q].z), bfhi(qn[q].z), bflo(qn[q].w), bfhi(qn[q].w)};
        const float x1a = bflo(q1[q]), x1b = bfhi(q1[q]), x2a = bflo(q2[q]), x2b = bfhi(q2[q]);
        float s_ = (x1a * x1a + x1b * x1b) + (x2a * x2a + x2b * x2b);
#pragma unroll
        for (int j = 0; j < 8; ++j) s_ += x[j] * x[j];
        s_ += __shfl_xor(s_, 1); s_ += __shfl_xor(s_, 2); s_ += __shfl_xor(s_, 4); s_ += __shfl_xor(s_, 8);
        const float rs = __builtin_amdgcn_rsqf(s_ * (1.0f / 192.0f) + EPS) * SCQ;
        u32x4 o; o.x = pk2(x[0] * qgn[0] * rs, x[1] * qgn[1] * rs); o.y = pk2(x[2] * qgn[2] * rs, x[3] * qgn[3] * rs); o.z = pk2(x[4] * qgn[4] * rs, x[5] * qgn[5] * rs); o.w = pk2(x[6] * qgn[6] * rs, x[7] * qgn[7] * rs);
        const float a0 = x1a * qg1a * rs, a1 = x1b * qg1b * rs, b0 = x2a * qg2a * rs, b1 = x2b * qg2b * rs;
        *(u32x4*)(qp + 8 * li) = o;
        *(unsigned*)(qp + 128 + 2 * li) = pk2(a0 * cs[q][0] - b0 * sn[q][0], a1 * cs[q][1] - b1 * sn[q][1]);
        *(unsigned*)(qp + 160 + 2 * li) = pk2(b0 * cs[q][0] + a0 * sn[q][0], b1 * cs[q][1] + a1 * sn[q][1]); }
      { bf16_t* kp = KK + (size_t)r * 768 + hd * 192;
        float x[8] = {bflo(kn[q].x), bfhi(kn[q].x), bflo(kn[q].y), bfhi(kn[q].y), bflo(kn[q].z), bfhi(kn[q].z), bflo(kn[q].w), bfhi(kn[q].w)};
        const float x1a = bflo(k1[q]), x1b = bfhi(k1[q]), x2a = bflo(k2[q]), x2b = bfhi(k2[q]);
        float s_ = (x1a * x1a + x1b * x1b) + (x2a * x2a + x2b * x2b);
#pragma unroll
        for (int j = 0; j < 8; ++j) s_ += x[j] * x[j];
        s_ += __shfl_xor(s_, 1); s_ += __shfl_xor(s_, 2); s_ += __shfl_xor(s_, 4); s_ += __shfl_xor(s_, 8);
        const float rs = __builtin_amdgcn_rsqf(s_ * (1.0f / 192.0f) + EPS);
        u32x4 o; o.x = pk2(x[0] * kgn[0] * rs, x[1] * kgn[1] * rs); o.y = pk2(x[2] * kgn[2] * rs, x[3] * kgn[3] * rs); o.z = pk2(x[4] * kgn[4] * rs, x[5] * kgn[5] * rs); o.w = pk2(x[6] * kgn[6] * rs, x[7] * kgn[7] * rs);
        const float a0 = x1a * kg1a * rs, a1 = x1b * kg1b * rs, b0 = x2a * kg2a * rs, b1 = x2b * kg2b * rs;
        *(u32x4*)(kp + 8 * li) = o;
        *(unsigned*)(kp + 128 + 2 * li) = pk2(a0 * cs[q][0] - b0 * sn[q][0], a1 * cs[q][1] - b1 * sn[q][1]);
        *(unsigned*)(kp + 160 + 2 * li) = pk2(b0 * cs[q][0] + a0 * sn[q][0], b1 * cs[q][1] + a1 * sn[q][1]); } }
  }
}

constexpr int HROW = 144;
constexpr int QROW = 272;
DI float clampe(float x) { return fminf(fmaxf(x, -80.f), 80.f); }
template <int OFF>
DI void h1_produce(const float (&b)[64], float blast, const bf16_t* vcol, LAS unsigned char* kd_row, LAS unsigned char* vt_row) {
  unsigned kw[16], vw[16];
#pragma unroll
  for (int i = 0; i < 32; i += 2) {
    const int s0 = OFF + i, s1 = OFF + i + 1;
    const float lf0 = s0 == 0 ? b[0] : b[s0] - b[s0 - 1], lf1 = b[s1] - b[s1 - 1];
    const float k0 = (1.0f - fexp(lf0)) * fexp(blast - b[s0]), k1 = (1.0f - fexp(lf1)) * fexp(blast - b[s1]);
    kw[i >> 1] = pk2(k0, k1);
    vw[i >> 1] = (unsigned)vcol[(size_t)s0 * 512] | ((unsigned)vcol[(size_t)s1 * 512] << 16);
  }
#pragma unroll
  for (int q = 0; q < 4; ++q) {
    *(LAS u32x4*)(kd_row + OFF * 2 + 16 * q) = (u32x4){kw[4 * q], kw[4 * q + 1], kw[4 * q + 2], kw[4 * q + 3]};
    *(LAS u32x4*)(vt_row + OFF * 2 + 16 * q) = (u32x4){vw[4 * q], vw[4 * q + 1], vw[4 * q + 2], vw[4 * q + 3]};
  }
}
DI void h1_unit(KP P, LAS unsigned char* lds, int gc, int hp) {
  const int tid = otid(), wave = tid >> 6, lane = tid & 63, r31 = lane & 31, hh = lane >> 5;
  const int thalf = tid >> 8, hd2 = (tid >> 7) & 1, k = tid & 127; const int head = 2 * hp + hd2, col = head * 128 + k;
  const _Float16* LOGF = (const _Float16*)(opq(P->ws) + OFF_BIG + B_LOGF); const bf16_t* VH = (const bf16_t*)(opq(P->ws) + OFF_BIG + B_VH);
  float* DEC = (float*)(opq(P->ws) + OFF_DEC); bf16_t* ST = (bf16_t*)(opq(P->ws) + OFF_BIG + B_ST);
  const size_t r0 = (size_t)gc * 64;
  LAS unsigned char* KD = lds; LAS unsigned char* VTL = lds + 2 * 128 * HROW;
  float b[64];
#pragma unroll
  for (int s = 0; s < 64; ++s) b[s] = (float)LOGF[(r0 + s) * 512 + col];
#pragma unroll
  for (int s = 1; s < 64; ++s) b[s] += b[s - 1];
  const float blast = b[63];
  if (thalf == 0) { DEC[(size_t)gc * 512 + col] = fexp(blast);
    h1_produce<0>(b, blast, VH + r0 * 512 + col, KD + (hd2 * 128 + k) * HROW, VTL + (hd2 * 128 + k) * HROW); }
  else h1_produce<32>(b, blast, VH + r0 * 512 + col, KD + (hd2 * 128 + k) * HROW, VTL + (hd2 * 128 + k) * HROW);
  __syncthreads();
  { const int whd = wave >> 2, kt = wave & 3;
    f32x16 acc[4];
#pragma unroll
    for (int vt = 0; vt < 4; ++vt)
#pragma unroll
      for (int i = 0; i < 16; ++i) acc[vt][i] = 0.f;
    const LAS unsigned char* ka = KD + (whd * 128 + kt * 32 + r31) * HROW + 16 * hh;
    const LAS unsigned char* vb = VTL + (whd * 128 + r31) * HROW + 16 * hh;
#pragma unroll
    for (int ks = 0; ks < 4; ++ks) { const bf16x8 a = *(const LAS bf16x8*)(ka + 32 * ks);
#pragma unroll
      for (int vt = 0; vt < 4; ++vt) { const bf16x8 bb = *(const LAS bf16x8*)(vb + vt * 32 * HROW + 32 * ks); acc[vt] = MFMA32(a, bb, acc[vt]); } }
    bf16_t* sp = ST + ((size_t)(gc * 4 + 2 * hp + whd) * 128) * 128 + kt * 32 + 4 * hh;
#pragma unroll
    for (int vt = 0; vt < 4; ++vt)
#pragma unroll
      for (int rq = 0; rq < 4; ++rq)
        *(u32x2*)(sp + (size_t)(vt * 32 + r31) * 128 + 8 * rq) = (u32x2){pk2(acc[vt][4 * rq], acc[vt][4 * rq + 1]), pk2(acc[vt][4 * rq + 2], acc[vt][4 * rq + 3])};
  }
  __syncthreads();
}
DI void phase_h2(KP P, int wg, int nwg) {
  u32x2* STw = (u32x2*)(opq(P->ws) + OFF_BIG + B_ST); const float* DEC = (const float*)(opq(P->ws) + OFF_DEC);
  for (int g = wg; g < 64; g += nwg) {
    const int gid = g * 512 + otid(); const int b = gid >> 14, rem = gid & 16383, hd = rem >> 12, kq = rem & 31;
    u32x2* sp = STw + (size_t)b * NCH * 16384 + rem;
    const f32x4* dp = (const f32x4*)(DEC + (size_t)b * NCH * 512 + hd * 128 + 4 * kq);
    float s0 = 0.f, s1 = 0.f, s2 = 0.f, s3 = 0.f;
    for (int c0 = 0; c0 < NCH; c0 += 24) {
      u32x2 uu[24]; f32x4 dd[24];
#pragma unroll
      for (int i = 0; i < 24; ++i) if (c0 + i < NCH) { uu[i] = sp[(size_t)(c0 + i) * 16384]; dd[i] = dp[(size_t)(c0 + i) * 128]; }
#pragma unroll
      for (int i = 0; i < 24; ++i) if (c0 + i < NCH) { sp[(size_t)(c0 + i) * 16384] = (u32x2){pk2(s0, s1), pk2(s2, s3)};
        s0 = dd[i][0] * s0 + bflo(uu[i].x); s1 = dd[i][1] * s1 + bfhi(uu[i].x); s2 = dd[i][2] * s2 + bflo(uu[i].y); s3 = dd[i][3] * s3 + bfhi(uu[i].y); }
    }
  }
}
template <int OFF>
DI void h3_produce(const float (&b)[64], float bref, const bf16_t* qcol, const bf16_t* vcol, LAS unsigned char* qm_col, LAS unsigned char* km_col, LAS unsigned char* vt_row) {
  unsigned vw[16];
#pragma unroll
  for (int i = 0; i < 32; ++i) { const int s = OFF + i;
    const float lf = s == 0 ? b[0] : b[s] - b[s - 1];
    const float q = bf2f(qcol[(size_t)s * 512]);
    const float qm = q * fexp(clampe(b[s] - bref)); const float km = (1.0f - fexp(lf)) * fexp(clampe(bref - b[s]));
    *(LAS bf16_t*)(qm_col + s * QROW) = (bf16_t)(pk2(qm, 0.f) & 0xffffu);
    *(LAS bf16_t*)(km_col + s * QROW) = (bf16_t)(pk2(km, 0.f) & 0xffffu);
    const unsigned v = vcol[(size_t)s * 512];
    if (i & 1) vw[i >> 1] |= v << 16; else vw[i >> 1] = v; }
#pragma unroll
  for (int q = 0; q < 4; ++q) *(LAS u32x4*)(vt_row + OFF * 2 + 16 * q) = (u32x4){vw[4 * q], vw[4 * q + 1], vw[4 * q + 2], vw[4 * q + 3]};
}
DI void h3_unit(KP P, int e, LAS unsigned char* lds, int gc, int hp) {
  const int tid = otid(), wave = tid >> 6, lane = tid & 63, r31 = lane & 31, hh = lane >> 5;
  const _Float16* LOGF = (const _Float16*)(opq(P->ws) + OFF_BIG + B_LOGF); const bf16_t* VH = (const bf16_t*)(opq(P->ws) + OFF_BIG + B_VH);
  const bf16_t* QH = (const bf16_t*)(opq(P->ws) + OFF_BIG + B_QH); const bf16_t* GT = (const bf16_t*)(opq(P->ws) + OFF_BIG + B_GT);
  const bf16_t* ST = (const bf16_t*)(opq(P->ws) + OFF_BIG + B_ST); bf16_t* MIX = (bf16_t*)(opq(P->ws) + OFF_U);
  const size_t r0 = (size_t)gc * 64;
  LAS unsigned char* QM = lds; LAS unsigned char* KM = lds + 2 * 64 * QROW; LAS unsigned char* VTL = lds + 4 * 64 * QROW;
  LAS float* EREF = (LAS float*)(lds + 4 * 64 * QROW + 2 * 128 * HROW); LAS float* RED = EREF + 256;
  { const int thalf = tid >> 8, hd2 = (tid >> 7) & 1, k = tid & 127; const int head = 2 * hp + hd2, col = head * 128 + k;
    float b[64];
#pragma unroll
    for (int s = 0; s < 64; ++s) b[s] = (float)LOGF[(r0 + s) * 512 + col];
#pragma unroll
    for (int s = 1; s < 64; ++s) b[s] += b[s - 1];
    const float bref = b[31];
    LAS unsigned char* qc = QM + hd2 * 64 * QROW + k * 2; LAS unsigned char* kc = KM + hd2 * 64 * QROW + k * 2; LAS unsigned char* vr = VTL + (hd2 * 128 + k) * HROW;
    if (thalf == 0) { EREF[hd2 * 128 + k] = fexp(bref); h3_produce<0>(b, bref, QH + r0 * 512 + col, VH + r0 * 512 + col, qc, kc, vr); }
    else h3_produce<32>(b, bref, QH + r0 * 512 + col, VH + r0 * 512 + col, qc, kc, vr);
  }
  const int hd2 = wave >> 2, tq = (wave >> 1) & 1, vh = wave & 1; const int head = 2 * hp + hd2;
  u32x4 sraw[2][8]; u32x2 gtv[2][4];
  { const bf16_t* sg0 = ST + ((size_t)(gc * 4 + head) * 128 + vh * 64 + r31) * 128 + 8 * hh;
#pragma unroll
    for (int vt = 0; vt < 2; ++vt)
#pragma unroll
      for (int ks = 0; ks < 8; ++ks) sraw[vt][ks] = *(const u32x4*)(sg0 + (size_t)vt * 32 * 128 + 16 * ks);
    const size_t row0 = r0 + 32 * tq + r31;
#pragma unroll
    for (int vt = 0; vt < 2; ++vt)
#pragma unroll
      for (int rq = 0; rq < 4; ++rq) gtv[vt][rq] = *(const u32x2*)(GT + row0 * 512 + head * 128 + vh * 64 + vt * 32 + 8 * rq + 4 * hh); }
  __syncthreads();
  f32x16 acc[2];
#pragma unroll
  for (int i = 0; i < 16; ++i) { acc[0][i] = 0.f; acc[1][i] = 0.f; }
  const LAS unsigned char* qb = QM + (hd2 * 64 + 32 * tq + r31) * QROW + 16 * hh;
  const LAS unsigned char* vb = VTL + (hd2 * 128 + vh * 64 + r31) * HROW + 16 * hh;
#pragma unroll
  for (int st = 0; st < 2; ++st) {
    if (st <= tq) {
      f32x16 att;
#pragma unroll
      for (int i = 0; i < 16; ++i) att[i] = 0.f;
      const LAS unsigned char* kb = KM + (hd2 * 64 + 32 * st + perm32k(r31)) * QROW + 16 * hh;
#pragma unroll
      for (int ks = 0; ks < 8; ++ks) { const bf16x8 a = *(const LAS bf16x8*)(kb + 32 * ks); const bf16x8 bq = *(const LAS bf16x8*)(qb + 32 * ks); att = MFMA32(a, bq, att); }
      if (st == tq) {
#pragma unroll
        for (int reg = 0; reg < 16; ++reg) { const int sl = (reg & 3) + 8 * hh + 4 * ((reg >> 2) & 1) + 16 * (reg >> 3); if (sl > r31) att[reg] = 0.f; } }
#pragma unroll
      for (int s2 = 0; s2 < 2; ++s2) { const bf16x8 pf = pack8(att, s2);
#pragma unroll
        for (int vt = 0; vt < 2; ++vt) { const bf16x8 a = *(const LAS bf16x8*)(vb + vt * 32 * HROW + (32 * st + 16 * s2) * 2); acc[vt] = MFMA32(a, pf, acc[vt]); } }
    }
  }
  { const LAS float* er = EREF + hd2 * 128 + 8 * hh;
#pragma unroll
    for (int ks = 0; ks < 8; ++ks) { const bf16x8 bq = *(const LAS bf16x8*)(qb + 32 * ks);
      const f32x4 e0 = *(const LAS f32x4*)(er + 16 * ks), e1 = *(const LAS f32x4*)(er + 16 * ks + 4);
#pragma unroll
      for (int vt = 0; vt < 2; ++vt) { const u32x4 raw = sraw[vt][ks];
        u32x4 w; w.x = pk2(bflo(raw.x) * e0[0], bfhi(raw.x) * e0[1]); w.y = pk2(bflo(raw.y) * e0[2], bfhi(raw.y) * e0[3]); w.z = pk2(bflo(raw.z) * e1[0], bfhi(raw.z) * e1[1]); w.w = pk2(bflo(raw.w) * e1[2], bfhi(raw.w) * e1[3]);
        acc[vt] = MFMA32(__builtin_bit_cast(bf16x8, w), bq, acc[vt]); } } }
  float ss = 0.f;
#pragma unroll
  for (int i = 0; i < 16; ++i) ss += acc[0][i] * acc[0][i] + acc[1][i] * acc[1][i];
  ss += __shfl_xor(ss, 32);
  if (hh == 0) RED[((hd2 * 2 + tq) * 2 + vh) * 32 + r31] = ss;
  __syncthreads();
  const float tot = RED[((hd2 * 2 + tq) * 2 + 0) * 32 + r31] + RED[((hd2 * 2 + tq) * 2 + 1) * 32 + r31];
  const float rstd = __builtin_amdgcn_rsqf(tot * (1.0f / 128.0f) + EPS);
  const size_t row = r0 + 32 * tq + r31; const float* og = P->hgrn_out_norm + e * 128;
#pragma unroll
  for (int vt = 0; vt < 2; ++vt)
#pragma unroll
    for (int rq = 0; rq < 4; ++rq) { const int v = vh * 64 + vt * 32 + 8 * rq + 4 * hh;
      const u32x2 gt = gtv[vt][rq]; const f32x4 gn = *(const f32x4*)(og + v);
      const float o0 = acc[vt][4 * rq] * rstd * gn[0] * bflo(gt.x), o1 = acc[vt][4 * rq + 1] * rstd * gn[1] * bfhi(gt.x), o2 = acc[vt][4 * rq + 2] * rstd * gn[2] * bflo(gt.y), o3 = acc[vt][4 * rq + 3] * rstd * gn[3] * bfhi(gt.y);
      *(u32x2*)(MIX + row * 1024 + head * 128 + v) = (u32x2){pk2(o0, o1), pk2(o2, o3)}; }
}

constexpr int KROWB = 400, ATT_KB = 64 * KROWB, ATT_VB = 128 * HROW;
DI void attn_unit(LAS unsigned char* lds, const bf16_t* __restrict__ Q, const bf16_t* __restrict__ Kg, const bf16_t* __restrict__ VT, bf16_t* __restrict__ MIX, int b, int h, int c0, int nq, int desc) {
  const int tid = otid(), wave = tid >> 6, lane = tid & 63, r31 = lane & 31, hh = lane >> 5;
  const bool active = (wave >> 1) < nq; const int cq = c0 + (wave >> 1); const int nt = c0 + nq;
  const size_t qrow = (size_t)b * LP + 64 * c0 + (active ? 32 * wave + r31 : 0);
  bf16x8 qf[12];
  { const bf16_t* qp = Q + qrow * 768 + h * 192 + 8 * hh;
#pragma unroll
    for (int s = 0; s < 12; ++s) qf[s] = *(const bf16x8*)(qp + 16 * s); }
  f32x16 O[4];
#pragma unroll
  for (int d = 0; d < 4; ++d)
#pragma unroll
    for (int i = 0; i < 16; ++i) O[d][i] = 0.f;
  float mrun = NEG_INF, lrun = 0.f;
  const bf16_t* kbase = Kg + (size_t)b * LP * 768 + h * 192;
  const bf16_t* vbase = VT + (size_t)(b * 4 + h) * 128 * LP;
  u32x4 kreg[3], vreg[2];
#define ATT_LOAD(t) do { _Pragma("unroll") for (int i = 0; i < 3; ++i) { const int ci = tid + 512 * i; const int rr = ci / 24, ch = ci % 24; kreg[i] = *(const u32x4*)(kbase + (size_t)(64 * (t) + rr) * 768 + ch * 8); } \
    _Pragma("unroll") for (int i = 0; i < 2; ++i) { const int ci = tid + 512 * i; const int dd = ci >> 3, ch = ci & 7; vreg[i] = *(const u32x4*)(vbase + (size_t)dd * LP + 64 * (t) + ch * 8); } } while (0)
#define ATT_STORE(buf) do { _Pragma("unroll") for (int i = 0; i < 3; ++i) { const int ci = tid + 512 * i; const int rr = ci / 24, ch = ci % 24; *(LAS u32x4*)(lds + (buf) * ATT_KB + rr * KROWB + ch * 16) = kreg[i]; } \
    _Pragma("unroll") for (int i = 0; i < 2; ++i) { const int ci = tid + 512 * i; const int dd = ci >> 3, ch = ci & 7; *(LAS u32x4*)(lds + 2 * ATT_KB + (buf) * ATT_VB + dd * HROW + ch * 16) = vreg[i]; } } while (0)
  const unsigned kgo = (unsigned)((tid >> 3) * 768 + (tid & 7) * 8), klo = (unsigned)((tid >> 3) * KROWB + (tid & 7) * 16);
  const unsigned vgo = (unsigned)((tid >> 2) * LP + (tid & 3) * 8), vlo = (unsigned)(2 * ATT_KB + (tid >> 2) * HROW + (tid & 3) * 16);
#define ATT_LOADK(t) do { const bf16_t* kp_ = kbase + (size_t)(64 * (t)) * 768 + kgo; _Pragma("unroll") for (int i = 0; i < 3; ++i) kreg[i] = *(const u32x4*)(kp_ + 64 * i); } while (0)
#define ATT_LOADV(t) do { const bf16_t* vp_ = vbase + 64 * (t) + vgo; _Pragma("unroll") for (int i = 0; i < 2; ++i) vreg[i] = *(const u32x4*)(vp_ + 32 * i); } while (0)
#define ATT_STOREK(buf) do { _Pragma("unroll") for (int i = 0; i < 3; ++i) *(LAS u32x4*)(lds + (buf) * ATT_KB + klo + 128 * i) = kreg[i]; } while (0)
#define ATT_STOREV(buf) do { _Pragma("unroll") for (int i = 0; i < 2; ++i) *(LAS u32x4*)(lds + (buf) * ATT_VB + vlo + 64 * i) = vreg[i]; } while (0)
#define ATT_QK(buf, S0, S1) do { _Pragma("unroll") for (int i = 0; i < 16; ++i) { S0[i] = 0.f; S1[i] = 0.f; } \
    const LAS unsigned char* kb_ = lds + (buf) * ATT_KB + perm32k(r31) * KROWB + 16 * hh; \
    _Pragma("unroll") for (int s = 0; s < 12; ++s) { const bf16x8 a0 = *(const LAS bf16x8*)(kb_ + 32 * s); const bf16x8 a1 = *(const LAS bf16x8*)(kb_ + 32 * KROWB + 32 * s); \
      S0 = MFMA32(a0, qf[s], S0); S1 = MFMA32(a1, qf[s], S1); } } while (0)
  f32x16 s0, s1, n0, n1;
#define TAU(t) (desc ? nt - 1 - (t) : (t))
  ATT_LOADK(TAU(0)); ATT_LOADV(TAU(0)); ATT_STOREK(0); ATT_STOREV(0);
  if (nt > 1) { ATT_LOADK(TAU(1)); ATT_STOREK(1); }
  __syncthreads();
  if (active) ATT_QK(0, s0, s1);
  __syncthreads();
  for (int t = 0; t < nt; ++t) {
    const int buf = t & 1; const int tau = TAU(t), taun = TAU(t + 1);
    if (t + 2 < nt) ATT_LOADK(TAU(t + 2));
    if (t + 1 < nt) ATT_LOADV(taun);
    const bool do_cur = active && tau <= cq; const bool do_next = active && (taun <= cq) && (t + 1 < nt);
    if (do_cur && do_next && tau != 0) {
      float mx = fmaxf(s0[0], s1[0]);
#pragma unroll
      for (int i = 1; i < 16; ++i) mx = fmaxf(mx, fmaxf(s0[i], s1[i]));
      mx = fmaxf(mx, __shfl_xor(mx, 32));
      const float mn = fmaxf(mrun, mx);
      if (__builtin_amdgcn_ballot_w64(mn > mrun) != 0ull) {
        const float alpha = __builtin_amdgcn_exp2f(mrun - mn); mrun = mn; lrun *= alpha;
#pragma unroll
        for (int d = 0; d < 4; ++d) O[d] = O[d] * alpha; }
#pragma unroll
      for (int i = 0; i < 16; ++i) { n0[i] = 0.f; n1[i] = 0.f; }
      const LAS unsigned char* kb2 = lds + (buf ^ 1) * ATT_KB + perm32k(r31) * KROWB + 16 * hh;
      __builtin_amdgcn_sched_barrier(0);
#pragma unroll
      for (int sx = 0; sx < 12; ++sx) { const bf16x8 a0 = *(const LAS bf16x8*)(kb2 + 32 * sx); const bf16x8 a1 = *(const LAS bf16x8*)(kb2 + 32 * KROWB + 32 * sx);
        n0 = MFMA32(a0, qf[sx], n0); n1 = MFMA32(a1, qf[sx], n1);
#pragma unroll
        for (int j = 0; j < 3; ++j) { const int ei = 3 * sx + j; if (ei < 16) s0[ei] = __builtin_amdgcn_exp2f(s0[ei] - mrun); else if (ei < 32) s1[ei - 16] = __builtin_amdgcn_exp2f(s1[ei - 16] - mrun); }
        __builtin_amdgcn_sched_barrier(0); }
      float ps = 0.f;
#pragma unroll
      for (int i = 0; i < 16; ++i) ps += s0[i] + s1[i];
      lrun += ps;
      bf16x8 pf[4]; pf[0] = pack8(s0, 0); pf[1] = pack8(s0, 1); pf[2] = pack8(s1, 0); pf[3] = pack8(s1, 1);
      const LAS unsigned char* vb = lds + 2 * ATT_KB + buf * ATT_VB + r31 * HROW + 16 * hh;
#pragma unroll
      for (int kk = 0; kk < 4; ++kk)
#pragma unroll
        for (int d = 0; d < 4; ++d) { const bf16x8 a = *(const LAS bf16x8*)(vb + d * 32 * HROW + 32 * kk); O[d] = MFMA32(a, pf[kk], O[d]); }
    } else {
    if (do_next) ATT_QK(buf ^ 1, n0, n1);
    if (do_cur) {
      if (tau == 0) {
#pragma unroll
        for (int i = 0; i < 16; ++i) s0[i] = NEG_INF;
#pragma unroll
        for (int i = 0; i < 8; ++i) s1[i] = NEG_INF; }
      float mx = fmaxf(s0[0], s1[0]);
#pragma unroll
      for (int i = 1; i < 16; ++i) mx = fmaxf(mx, fmaxf(s0[i], s1[i]));
      mx = fmaxf(mx, __shfl_xor(mx, 32));
      const float mn = fmaxf(mrun, mx);
      if (__builtin_amdgcn_ballot_w64(mn > mrun) != 0ull) {
        const float alpha = __builtin_amdgcn_exp2f(mrun - mn); mrun = mn; lrun *= alpha;
#pragma unroll
        for (int d = 0; d < 4; ++d) O[d] = O[d] * alpha; }
      float ps = 0.f;
#pragma unroll
      for (int i = 0; i < 16; ++i) { s0[i] = __builtin_amdgcn_exp2f(s0[i] - mrun); s1[i] = __builtin_amdgcn_exp2f(s1[i] - mrun); ps += s0[i] + s1[i]; }
      lrun += ps;
      bf16x8 pf[4]; pf[0] = pack8(s0, 0); pf[1] = pack8(s0, 1); pf[2] = pack8(s1, 0); pf[3] = pack8(s1, 1);
      const LAS unsigned char* vb = lds + 2 * ATT_KB + buf * ATT_VB + r31 * HROW + 16 * hh;
#pragma unroll
      for (int kk = 0; kk < 4; ++kk)
#pragma unroll
        for (int d = 0; d < 4; ++d) { const bf16x8 a = *(const LAS bf16x8*)(vb + d * 32 * HROW + 32 * kk); O[d] = MFMA32(a, pf[kk], O[d]); }
    }
    }
    if (t + 2 < nt) ATT_STOREK(buf);
    if (t + 1 < nt) ATT_STOREV(buf ^ 1);
    __syncthreads();
    s0 = n0; s1 = n1;
  }
#undef ATT_LOADK
#undef ATT_LOADV
#undef ATT_STOREK
#undef ATT_STOREV
#undef ATT_QK
#undef TAU
#undef ATT_LOAD
#undef ATT_STORE
  if (active) {
    const float lt = lrun + __shfl_xor(lrun, 32); const float inv = 1.0f / lt;
    bf16_t* op = MIX + qrow * 1024 + 512 + h * 128 + 4 * hh;
#pragma unroll
    for (int d = 0; d < 4; ++d)
#pragma unroll
      for (int rq = 0; rq < 4; ++rq)
        *(u32x2*)(op + d * 32 + 8 * rq) = (u32x2){pk2(O[d][4 * rq] * inv, O[d][4 * rq + 1] * inv), pk2(O[d][4 * rq + 2] * inv, O[d][4 * rq + 3] * inv)};
  }
}
DI void phase_attn(KP P, LAS unsigned char* lds) {
  const bf16_t* Q = (const bf16_t*)(opq(P->ws) + OFF_BIG + B_QP); const bf16_t* Kg = (const bf16_t*)(opq(P->ws) + OFF_BIG + B_KK); const bf16_t* VT = (const bf16_t*)(opq(P->ws) + OFF_BIG + B_VT);
  bf16_t* MIX = (bf16_t*)(opq(P->ws) + OFF_U);
  for (int j = obid(); j < 256; j += ogrid()) {
    const int bh = j & 7, pi = j >> 3; const int b = bh >> 2, h = bh & 3;
    attn_unit(lds, Q, Kg, VT, MIX, b, h, 4 * (64 - pi) - 3, 4, 0);
    attn_unit(lds, Q, Kg, VT, MIX, b, h, 4 * (pi + 1) - 3, 4, 1);
    if (pi == 31) attn_unit(lds, Q, Kg, VT, MIX, b, h, 0, 1, 0);
  }
}


#define XB_TMO      128
#define XB_XCNT(j)  (256  + 64 * (j))
#define XB_XSUB(j)  (1280 + 64 * (j))
#define XB_XGEN(j)  (2304 + 64 * (j))
#define XB_TOP      3328
#define XB_TOPGEN   3392
#define XCD_BAR_WORDS 3456
#define XB_SPIN_CAP (1u << 20)
DI unsigned xb_ld(unsigned* p)              { return __hip_atomic_load(p, __ATOMIC_RELAXED, __HIP_MEMORY_SCOPE_AGENT); }
DI unsigned xb_add(unsigned* p, unsigned v) { return __hip_atomic_fetch_add(p, v, __ATOMIC_RELAXED, __HIP_MEMORY_SCOPE_AGENT); }
DI unsigned xb_xcc_id() { return (unsigned)__builtin_amdgcn_s_getreg((3 << 11) | 20) & 0xFu; }
#define XB_SPIN(cond, bar) do { unsigned _sp = 0; while (cond) { __builtin_amdgcn_s_sleep(1); \
    if ((++_sp & 255u) == 0u) { if (xb_ld(&(bar)[XB_TMO])) break; if (_sp > XB_SPIN_CAP) { atomicAdd(&(bar)[XB_TMO], 1u); break; } } } } while (0)
struct XcdBarrier { unsigned* bar; unsigned x; volatile LAS unsigned* st; };
DI XcdBarrier xcd_barrier_post(unsigned* bar, volatile LAS unsigned* st) {
  XcdBarrier b; b.bar = bar; b.x = xb_xcc_id(); b.st = st;
  if (threadIdx.x == 0) (void)xb_add(&bar[XB_XCNT(b.x)], 1u);
  return b;
}
DI void xcd_barrier_complete(unsigned* bar, unsigned x, unsigned& nloc, unsigned& nx) {
  const unsigned Gn = gridDim.x * gridDim.y * gridDim.z;
  unsigned sum, cnt, mine, sp = 0u;
  for (;;) {
    sum = 0u; cnt = 0u; mine = 0u;
#pragma unroll
    for (unsigned j = 0; j < 16; ++j) { const unsigned c = xb_ld(&bar[XB_XCNT(j)]); sum += c; cnt += (c > 0u) ? 1u : 0u; mine = (j == x) ? c : mine; }
    if (sum == Gn) break;
    __builtin_amdgcn_s_sleep(1);
    if ((++sp & 255u) == 0u) { if (xb_ld(&bar[XB_TMO])) break; if (sp > XB_SPIN_CAP) { atomicAdd(&bar[XB_TMO], 1u); break; } }
  }
  nloc = mine > 0u ? mine : 1u; nx = cnt > 0u ? cnt : 1u;
}
DI void xcd_barrier(const XcdBarrier& b) {
  asm volatile("s_waitcnt vmcnt(0)" ::: "memory");
  __syncthreads();
  if (threadIdx.x == 0) {
    unsigned* bar = b.bar;
    __builtin_amdgcn_s_waitcnt(0);
    unsigned nloc = b.st[0], nx = b.st[1];
    if (nloc == 0u) { xcd_barrier_complete(bar, b.x, nloc, nx); b.st[0] = nloc; b.st[1] = nx; }
    const unsigned old = xb_add(&bar[XB_XSUB(b.x)], 1u);
    const unsigned gen = old / nloc;
    if (old + 1u == (gen + 1u) * nloc) {
      __builtin_amdgcn_fence(__ATOMIC_RELEASE, "agent");
      asm volatile("s_waitcnt vmcnt(0)" ::: "memory");
      const unsigned og = xb_add(&bar[XB_TOP], 1u);
      const unsigned tg = og / nx;
      if (og + 1u == (tg + 1u) * nx) xb_add(&bar[XB_TOPGEN], 1u);
      else XB_SPIN(xb_ld(&bar[XB_TOPGEN]) == tg, bar);
      __builtin_amdgcn_fence(__ATOMIC_ACQUIRE, "agent");
      xb_add(&bar[XB_XGEN(b.x)], 1u);
      asm volatile("s_waitcnt vmcnt(0)" ::: "memory");
    } else {
      XB_SPIN(xb_ld(&bar[XB_XGEN(b.x)]) == gen, bar);
      __builtin_amdgcn_fence(__ATOMIC_ACQUIRE, "agent");
      asm volatile("s_waitcnt vmcnt(0)" ::: "memory");
    }
  }
  __syncthreads();
}
DI void tail_fixup(const HMap hm, bf16_t* HB, float* SSQH) {
  const int tid = otid(), wave = tid >> 6, lane = tid & 63;
  for (int r = 32768 + wave; r < MT; r += 8) {
    u32x2* o8 = (u32x2*)(HB + (size_t)r * 1024) + lane; float s = 0.f;
    if (!row_is_pad(r)) { const f32x4* xr = (const f32x4*)hptr(hm, r) + lane;
#pragma unroll
      for (int j = 0; j < 4; ++j) { const f32x4 v = xr[64 * j]; s += (v[0] * v[0] + v[1] * v[1]) + (v[2] * v[2] + v[3] * v[3]); o8[64 * j] = (u32x2){pk2(v[0], v[1]), pk2(v[2], v[3])}; }
    } else {
#pragma unroll
      for (int j = 0; j < 4; ++j) { const unsigned z0 = ouz(); o8[64 * j] = (u32x2){z0, z0}; } }
    s = wave_sum(s);
    if (lane < 16) SSQH[(size_t)r * 16 + lane] = lane == 0 ? s : 0.f;
  }
  asm volatile("s_waitcnt vmcnt(0)" ::: "memory");
}
#define P (kparams())
#define G (ogrid())
#define bid (obid())
template <int layer>
DI void run_layer(LAS unsigned char* lds, const XcdBarrier& xbar) {
    unsigned char* ws = opq(P->ws);
    bf16_t* U = (bf16_t*)(ws + OFF_U); unsigned char* BIG = ws + OFF_BIG;
    float* hside = (float*)(ws + OFF_HSIDE);
    const HMap hm0{P->x, P->meta, 0, nullptr}; const HMap hm1{P->out, hside, 16 * 1024, nullptr}; const HMap hm1b{P->out, hside, 16 * 1024, (const bf16_t*)P->out};
    const HMap hin = layer == 0 ? hm0 : hm1b;
    if ((layer & 1) == 0) {
      const int e = layer >> 1;
      { pg8::Gemm g{layer == 0 ? U : (const bf16_t*)P->out, (const bf16_t*)(ws + OFF_WIN), MT, INP, DM, DM, DM}; pg8::StaticOrder S; S.init(MT, INP, G, bid, 0);
        if (layer > 0) {
          bool own = false; { pg8::Unit uu; for (int i = 0; S.next(i, uu); ++i) own = own || (uu.pm == 128); }
          if (own) tail_fixup(hm1, (bf16_t*)P->out, (float*)(ws + OFF_SSQH));
          __syncthreads(); }
        EpiIn E{BIG, ws, e, layer > 0 ? (const float*)(ws + OFF_SSQH) : nullptr};
        pg8::gemm_phase(lds, g, S, E); }
      conv_bundle(P, layer, CB_UP, lds, 139);
      xcd_barrier(xbar);
      { if (G == 256) {
          for (int u = bid; u < 1024; u += G) h1_unit(P, lds, u >> 1, u & 1);
          if (bid >= 252) { const int u = 1024 + bid - 252; h1_unit(P, lds, u >> 1, u & 1); } }
        else { for (int u = bid; u < 1028; u += G) h1_unit(P, lds, u >> 1, u & 1); }
        { pg8::Gemm g{(const bf16_t*)(BIG + B_CQ), (const bf16_t*)(ws + OFF_WQ), MT, 768, 256, 256, 256}; pg8::StaticOrder S; S.init(MT, 768, G, bid, 0);
          EpiQ E{(bf16_t*)(BIG + B_QP), (const float*)(ws + OFF_SSQQ)}; pg8::gemm_phase(lds, g, S, E); }
        { pg8::Gemm g{(const bf16_t*)(BIG + B_CKV), (const bf16_t*)(ws + OFF_WKN), MT, 512, 256, 256, 256}; pg8::StaticOrder S; S.init(MT, 512, G, bid, 125);
          EpiKn E{(bf16_t*)(BIG + B_KK), (const float*)(ws + OFF_SSQKV)}; pg8::gemm_phase(lds, g, S, E); }
        { pg8::Gemm g{(const bf16_t*)(ws + OFF_WV), (const bf16_t*)(BIG + B_CKV), 512, MT, 256, 256, 256}; pg8::StaticOrder S; S.init(512, MT, G, bid, 123);
          EpiVt E{(bf16_t*)(BIG + B_VT), (const float*)(ws + OFF_SSQKV)}; pg8::gemm_phase(lds, g, S, E); } }
      xcd_barrier(xbar);
      { if (G >= 256) { if (bid < 64) phase_h2(P, bid, 64); else phase_qkfinal(P, e, bid - 64, G - 64); }
        else { phase_h2(P, bid, G); phase_qkfinal(P, e, bid, G); } }
      xcd_barrier(xbar);
      { phase_attn(P, lds);
#ifdef DUP_ATTN
        __syncthreads(); phase_attn(P, lds);
#endif
        for (int u = bid; u < 1028; u += G) h3_unit(P, e, lds, u >> 1, u & 1);
#ifdef DUP_H
        __syncthreads(); for (int u = bid; u < 1028; u += G) h3_unit(P, e, lds, u >> 1, u & 1);
#endif
        }
      xcd_barrier(xbar);
      { pg8::Gemm g{U, (const bf16_t*)(ws + OFF_WOUT), 32768, DM, DM, DM, DM}; pg8::StaticOrder S; S.init(32768, DM, G, bid, 0);
        EpiRes E{hin, hm1, nullptr, 0, (bf16_t*)(BIG + B_HB), (float*)(ws + OFF_SSQH), 0}; pg8::gemm_phase(lds, g, S, E); }
      { pg8::Gemm g{U + (size_t)32768 * DM, (const bf16_t*)(ws + OFF_WOUT), 256, DM, 256, DM, DM}; pg8::SplitOrder S; S.init(4, 4, 512u, G, bid, 64);
        EpiResAtomic E{hm1, 32768}; pg8::gemm_phase(lds, g, S, E); }
      xcd_barrier(xbar);
    } else {
      const int o = layer >> 1;
      phase_normpool(hm1b, P->mix_norm + layer * DM, (bf16_t*)BIG, lds);
      xcd_barrier(xbar);
#pragma unroll 1
      for (int gq = 0; gq < 4; ++gq) {
        pg8::Gemm g{(const bf16_t*)BIG + gq * 256, (const bf16_t*)(ws + OFF_WPOOL) + (size_t)gq * 65536, MT, 256, 256, DM, 256}; pg8::StaticOrder S; S.init(MT, 256, G, bid, (127 * gq) % G);
        EpiRes E{hin, hm1, P->pool_scale + o * DM, gq * 256, (bf16_t*)(BIG + B_HB), (float*)(ws + OFF_SSQH), 2}; pg8::gemm_phase(lds, g, S, E); }
      conv_bundle(P, layer, CB_UP, lds, 0);
      xcd_barrier(xbar);
    }
    { pg8::Gemm g{(const bf16_t*)(BIG + B_HB), (const bf16_t*)(ws + OFF_WUP), MT, DFF, DM, DM, DM}; pg8::StaticOrder S; S.init(MT, DFF, G, bid, 0);
      if ((layer & 1) == 0) {
        bool own = false; { pg8::Unit uu; for (int i = 0; S.next(i, uu); ++i) own = own || (uu.pm == 128); }
        if (own) tail_fixup(hm1, (bf16_t*)(BIG + B_HB), (float*)(ws + OFF_SSQH));
        __syncthreads(); }
      EpiUp E{(bf16_t*)BIG, (const float*)(ws + OFF_SSQH)}; pg8::gemm_phase(lds, g, S, E);
    }
    conv_bundle(P, layer, CB_DN, lds, 16);
    if (layer < 3) conv_bundle(P, layer + 1, CB_MIX, lds, 16);
    xcd_barrier(xbar);
    { pg8::Gemm g{(const bf16_t*)BIG, (const bf16_t*)(ws + OFF_WDN), 32768, DM, DFF, DFF, DFF}; pg8::StaticOrder S; S.init(32768, DM, G, bid, 0, 1);
      EpiResB E{(const bf16_t*)(BIG + B_HB), layer < 3 ? hm1b : hm1, layer == 1 ? (float*)(ws + OFF_SSQH) : nullptr}; pg8::gemm_phase(lds, g, S, E); }
    { pg8::Gemm g{(const bf16_t*)BIG + (size_t)32768 * DFF, (const bf16_t*)(ws + OFF_WDN), 256, DM, 256, DFF, DFF}; pg8::SplitOrder S; S.init(4, 16, 512u, G, bid, 0);
      EpiResAtomic E{hm1, 32768}; pg8::gemm_phase(lds, g, S, E); }
    if (layer < 3) xcd_barrier(xbar);
}
__global__ void __launch_bounds__(512, 2) trunk_fwd(Params Parg) {
  extern __shared__ __attribute__((aligned(16))) unsigned char lds_raw[];
  LAS unsigned char* lds = (LAS unsigned char*)lds_raw;
  cg::grid_group grid = cg::this_grid();
  volatile LAS unsigned* xst = (volatile LAS unsigned*)(lds + 131072 + 64);
  if (threadIdx.x < 2) xst[threadIdx.x] = 0u;
  __syncthreads();
  if (blockIdx.x == 0) { unsigned* cw = (unsigned*)(opq(P->ws) + OFF_CTL);
    for (int i = threadIdx.x; i < (int)(CTL_BYTES / 4); i += 512) __hip_atomic_store(cw + i, 0u, __ATOMIC_RELAXED, __HIP_MEMORY_SCOPE_AGENT); }
  phase_tables(P);
  conv_bundle(P, 0, CB_MIX, lds, 0);
  { const HMap hm0{P->x, P->meta, 0, nullptr}; phase_norm(hm0, P->mix_norm, (bf16_t*)(opq(P->ws) + OFF_U)); }
  grid.sync();
  const XcdBarrier xbar = xcd_barrier_post((unsigned*)(opq(P->ws) + OFF_CTL), xst);
  run_layer<0>(lds, xbar);
  run_layer<1>(lds, xbar);
  run_layer<2>(lds, xbar);
  run_layer<3>(lds, xbar);
}

#undef P
#undef G
#undef bid
extern "C" void kernel_launch(void* const* d_in, const int* in_sizes, int n_in, void* d_out, int out_size, void* d_ws, size_t ws_size, hipStream_t stream) {
  static int grid = 0;
  if (grid == 0) {
    if (n_in != 18 || ws_size < WS_NEED) { fprintf(stderr, "kernel_launch: unexpected n_in %d / ws %zu (need %zu)\n", n_in, ws_size, (size_t)WS_NEED); grid = -1; return; }
    int dev = 0, cus = 0, per_cu = 0;
    (void)hipGetDevice(&dev); (void)hipDeviceGetAttribute(&cus, hipDeviceAttributeMultiprocessorCount, dev);
    if (hipFuncSetAttribute((const void*)trunk_fwd, hipFuncAttributeMaxDynamicSharedMemorySize, LDS_BYTES) != hipSuccess) { fprintf(stderr, "kernel_launch: hipFuncSetAttribute failed\n"); grid = -1; return; }
    if (hipOccupancyMaxActiveBlocksPerMultiprocessor(&per_cu, (const void*)trunk_fwd, 512, LDS_BYTES) != hipSuccess || per_cu < 1) { fprintf(stderr, "kernel_launch: occupancy query says %d\n", per_cu); per_cu = 1; }
    (void)hipGetLastError();
    grid = cus > 256 ? 256 : cus;
  }
  if (grid < 0) return;
  Params p{};
  const float** pp = (const float**)&p;
  for (int i = 0; i < 18; ++i) pp[i] = (const float*)d_in[i];
  p.out = (float*)d_out; p.ws = (unsigned char*)d_ws;
  void* args[] = {&p};
  hipError_t e = hipLaunchCooperativeKernel((const void*)trunk_fwd, dim3(grid), dim3(512), args, LDS_BYTES, stream);
  if (e != hipSuccess) fprintf(stderr, "cooperative launch failed: %s (grid %d)\n", hipGetErrorString(e), grid);
}
```
